# Optimizing an MI355X kernel written in HIP

```python
import math
import jax, jax.numpy as jnp
from jax import lax
import numpy as np

D_MODEL = 1024
BATCH = 4
SEQ = 8192
DEPTH = 2

GRID_W = 64
CTX_LEN = 256
D_MIX = D_MODEL
N_MIXERS = 4
GROUP_W = D_MIX // N_MIXERS
N_PARTS = 10
D_IN = N_PARTS * GROUP_W
CONV_A_K = 31
DIFF_HEADS = 4
DIFF_DQK = GROUP_W // (2 * DIFF_HEADS)
DIFF_DV = 2 * DIFF_DQK
ROPE_HALF = DIFF_DQK // 2
ROPE_BASE = 10000.0
Q_BLOCK = 128
CHUNK = 128
SG_GROUPS = 4
SG_DIM = GROUP_W // SG_GROUPS
CONV_D_K = 3
D_FF = 4 * D_MODEL
EPS = 1e-6

kernel_name = 'hybrid_parallel_group_dit_block'


def rms_norm(x, g):
    xf = x.astype(jnp.float32)
    y = xf * lax.rsqrt(jnp.mean(xf * xf, axis=-1, keepdims=True) + EPS)
    return (y * g.astype(jnp.float32)).astype(x.dtype)


def layer_norm(x, g, b):
    xf = x.astype(jnp.float32)
    xc = xf - jnp.mean(xf, axis=-1, keepdims=True)
    y = xc * lax.rsqrt(jnp.mean(xc * xc, axis=-1, keepdims=True) + EPS)
    return (y * g.astype(jnp.float32) + b.astype(jnp.float32)).astype(x.dtype)


def modulate(h, shift, scale):
    return h * (1 + scale) + shift


def depthwise_conv(x, w):
    pad = w.shape[0] // 2
    return lax.conv_general_dilated(
        x, w[:, None, :].astype(x.dtype), window_strides=(1,), padding=[(pad, pad)],
        dimension_numbers=('NWC', 'WIO', 'NWC'), feature_group_count=x.shape[-1])


def axial_rope(rows, dtype):
    row = jnp.repeat(jnp.arange(rows, dtype=jnp.float32), GRID_W)
    col = jnp.tile(jnp.arange(GRID_W, dtype=jnp.float32), rows)
    inv = ROPE_BASE ** (-jnp.arange(0, ROPE_HALF, 2, dtype=jnp.float32) / ROPE_HALF)
    ang_r = row[:, None] * inv
    ang_c = col[:, None] * inv
    return (jnp.cos(ang_r)[:, None, :].astype(dtype), jnp.sin(ang_r)[:, None, :].astype(dtype),
            jnp.cos(ang_c)[:, None, :].astype(dtype), jnp.sin(ang_c)[:, None, :].astype(dtype))


def rotate_pairs(t, cos, sin):
    f = t.shape[-1] // 2
    t1, t2 = t[..., :f], t[..., f:]
    return jnp.concatenate([t1 * cos - t2 * sin, t1 * sin + t2 * cos], axis=-1)


def apply_axial_rope(t, rope):
    cos_r, sin_r, cos_c, sin_c = rope
    return jnp.concatenate([rotate_pairs(t[..., :ROPE_HALF], cos_r, sin_r),
                            rotate_pairs(t[..., ROPE_HALF:], cos_c, sin_c)], axis=-1)


def qk_heads(t, rope):
    b, n, _ = t.shape
    t = t.reshape(b, n, DIFF_HEADS, 2, DIFF_DQK)
    t1, t2 = t[..., 0, :], t[..., 1, :]
    if rope is not None:
        t1, t2 = apply_axial_rope(t1, rope), apply_axial_rope(t2, rope)
    return t1, t2


def v_heads(t):
    b, n, _ = t.shape
    return t.reshape(b, n, DIFF_HEADS, DIFF_DV)


def diff_attention(q1, q2, k1, k2, v, lam, lam_init, subln_g):
    b, n = q1.shape[:2]
    nb = n // Q_BLOCK
    scale = DIFF_DQK ** -0.5

    def blocks(t):
        return t.reshape(b, nb, Q_BLOCK, DIFF_HEADS, DIFF_DQK).transpose(1, 0, 2, 3, 4)

    def one_block(qs):
        qb1, qb2 = qs
        p1 = jax.nn.softmax(jnp.einsum('bqhd,bkhd->bhqk', qb1, k1).astype(jnp.float32) * scale, axis=-1)
        p2 = jax.nn.softmax(jnp.einsum('bqhd,bkhd->bhqk', qb2, k2).astype(jnp.float32) * scale, axis=-1)
        w = (p1 - lam * p2).astype(v.dtype)
        return jnp.einsum('bhqk,bkhd->bqhd', w, v)

    o = lax.map(one_block, (blocks(q1), blocks(q2)))
    o = o.transpose(1, 0, 2, 3, 4).reshape(b, n, DIFF_HEADS, DIFF_DV)
    o = rms_norm(o, subln_g) * (1.0 - lam_init)
    return o.reshape(b, n, GROUP_W)


def conformer_conv(a_val, a_gate, conv_w, conv_b, ln_g, ln_b):
    glu = a_val * jax.nn.sigmoid(a_gate)
    y = depthwise_conv(glu, conv_w) + conv_b
    return jax.nn.silu(layer_norm(y, ln_g, ln_b))


def spatial_gating(u, v, ln_g, ln_b, w_s, b_s):
    u = jax.nn.gelu(u)
    v = layer_norm(jax.nn.gelu(v), ln_g, ln_b)
    b, n, _ = v.shape
    vc = v.reshape(b, n // CHUNK, CHUNK, SG_GROUPS, SG_DIM)
    s = jnp.einsum('gpq,bcqgd->bcpgd', w_s, vc) + b_s.T[:, :, None]
    return u * s.reshape(b, n, GROUP_W)


def short_conv_mixer(bg, cg, xin, conv_w):
    return bg * depthwise_conv(cg * xin, conv_w)


def token_mixers(z, k1, k2, v, rope, lam, lam_init, conv_a_w, conv_a_b, ln_a_g, ln_a_b, subln_g,
                 sg_ln_g, sg_ln_b, sg_w, sg_b, conv_d_w, w_out):
    a_val, a_gate, q, _, _, u, sv, bg, cg, xin = z
    y_a = conformer_conv(a_val, a_gate, conv_a_w, conv_a_b, ln_a_g, ln_a_b)
    q1, q2 = qk_heads(q, rope)
    y_b = diff_attention(q1, q2, k1, k2, v, lam, lam_init, subln_g)
    y_c = spatial_gating(u, sv, sg_ln_g, sg_ln_b, sg_w, sg_b)
    y_d = short_conv_mixer(bg, cg, xin, conv_d_w)
    return jnp.concatenate([y_a, y_b, y_c, y_d], axis=-1) @ w_out


def channel_mixer(h, w1, w2):
    return jnp.square(jax.nn.relu(h @ w1)) @ w2


def setup_inputs(seed: int = 0) -> dict:
    key = jax.random.key(seed)
    ks = jax.random.split(key, 32)

    def nrm(k, shape, scale):
        return jax.random.normal(k, shape, jnp.float32) * scale

    def gain(k, shape):
        return 1.0 + nrm(k, shape, 0.05)

    return {
        'x': nrm(ks[0], (BATCH, SEQ, D_MODEL), 1.0),
        'c': nrm(ks[1], (BATCH, D_MODEL), 1.0),
        'ctx': nrm(ks[2], (BATCH, CTX_LEN, D_MODEL), 1.0),
        'c_ctx': nrm(ks[3], (D_MODEL,), 1.0),
        'ada_w': nrm(ks[4], (DEPTH, D_MODEL, 6 * D_MODEL), 0.5 * D_MODEL ** -0.5),
        'ada_b': nrm(ks[5], (DEPTH, 6 * D_MODEL), 0.01),
        'norm1_g': gain(ks[6], (DEPTH, D_MODEL)),
        'norm2_g': gain(ks[7], (DEPTH, D_MODEL)),
        'w_in': nrm(ks[8], (DEPTH, D_MODEL, D_IN), D_MODEL ** -0.5),
        'conv_a_w': nrm(ks[9], (DEPTH, CONV_A_K, GROUP_W), CONV_A_K ** -0.5),
        'conv_a_b': nrm(ks[10], (DEPTH, GROUP_W), 0.01),
        'ln_a_g': gain(ks[11], (DEPTH, GROUP_W)),
        'ln_a_b': nrm(ks[12], (DEPTH, GROUP_W), 0.01),
        'lam_q1': nrm(ks[13], (DEPTH, DIFF_DQK), 0.1),
        'lam_k1': nrm(ks[14], (DEPTH, DIFF_DQK), 0.1),
        'lam_q2': nrm(ks[15], (DEPTH, DIFF_DQK), 0.1),
        'lam_k2': nrm(ks[16], (DEPTH, DIFF_DQK), 0.1),
        'subln_g': gain(ks[17], (DEPTH, DIFF_DV)),
        'sg_ln_g': gain(ks[18], (DEPTH, GROUP_W)),
        'sg_ln_b': nrm(ks[19], (DEPTH, GROUP_W), 0.01),
        'sg_w': nrm(ks[20], (DEPTH, SG_GROUPS, CHUNK, CHUNK), CHUNK ** -0.5),
        'sg_b': gain(ks[21], (DEPTH, SG_GROUPS, CHUNK)),
        'conv_d_w': nrm(ks[22], (DEPTH, CONV_D_K, GROUP_W), CONV_D_K ** -0.5),
        'w_out': nrm(ks[23], (DEPTH, D_MIX, D_MODEL), D_MIX ** -0.5),
        'mlp_w1': nrm(ks[24], (DEPTH, D_MODEL, D_FF), D_MODEL ** -0.5),
        'mlp_w2': nrm(ks[25], (DEPTH, D_FF, D_MODEL), D_FF ** -0.5),
        'final_g': gain(ks[26], (D_MODEL,)),
    }


def reference(x, c, ctx, c_ctx, ada_w, ada_b, norm1_g, norm2_g, w_in, conv_a_w, conv_a_b, ln_a_g,
              ln_a_b, lam_q1, lam_k1, lam_q2, lam_k2, subln_g, sg_ln_g, sg_ln_b, sg_w, sg_b, conv_d_w,
              w_out, mlp_w1, mlp_w2, final_g):
    ROWS = x.shape[1] // GRID_W
    rope = axial_rope(ROWS, x.dtype)
    h_ctx = ctx
    for l in range(DEPTH):
        lam_init = 0.8 - 0.6 * math.exp(-0.3 * l)
        lam = (jnp.exp(jnp.sum(lam_q1[l] * lam_k1[l]).astype(jnp.float32))
               - jnp.exp(jnp.sum(lam_q2[l] * lam_k2[l]).astype(jnp.float32)) + lam_init)
        mod_x = jnp.split((jax.nn.silu(c) @ ada_w[l] + ada_b[l])[:, None, :], 6, axis=-1)
        mod_c = jnp.split(jax.nn.silu(c_ctx) @ ada_w[l] + ada_b[l], 6, axis=-1)
        mix_args = (rope, lam, lam_init, conv_a_w[l], conv_a_b[l], ln_a_g[l], ln_a_b[l], subln_g[l],
                    sg_ln_g[l], sg_ln_b[l], sg_w[l], sg_b[l], conv_d_w[l], w_out[l])

        hc = modulate(rms_norm(h_ctx, norm1_g[l]), mod_c[0], mod_c[1])
        zc = jnp.split(hc @ w_in[l], N_PARTS, axis=-1)
        k1c, k2c = qk_heads(zc[3], None)
        vc = v_heads(zc[4])

        hx = modulate(rms_norm(x, norm1_g[l]), mod_x[0], mod_x[1])
        zx = jnp.split(hx @ w_in[l], N_PARTS, axis=-1)
        k1x, k2x = qk_heads(zx[3], rope)
        k1 = jnp.concatenate([k1c, k1x], axis=1)
        k2 = jnp.concatenate([k2c, k2x], axis=1)
        v = jnp.concatenate([vc, v_heads(zx[4])], axis=1)
        x = x + mod_x[2] * token_mixers(zx, k1, k2, v, *mix_args)
        x = x + mod_x[5] * channel_mixer(modulate(rms_norm(x, norm2_g[l]), mod_x[3], mod_x[4]),
                                         mlp_w1[l], mlp_w2[l])

        if l < DEPTH - 1:
            ctx_args = (None,) + mix_args[1:]
            h_ctx = h_ctx + mod_c[2] * token_mixers(zc, k1c, k2c, vc, *ctx_args)
            h_ctx = h_ctx + mod_c[5] * channel_mixer(
                modulate(rms_norm(h_ctx, norm2_g[l]), mod_c[3], mod_c[4]), mlp_w1[l], mlp_w2[l])
    return rms_norm(x, final_g)
```

```cpp
#include <hip/hip_runtime.h>
#include <hip/hip_cooperative_groups.h>
#include <cstdio>
#include <cstdint>
namespace cg = cooperative_groups;
namespace pg8 {
#define PG8_LAS __attribute__((address_space(3)))
typedef unsigned short bf16_t;
typedef short bf16x8 __attribute__((ext_vector_type(8)));
typedef float f32x4 __attribute__((ext_vector_type(4)));
typedef unsigned u32x4 __attribute__((ext_vector_type(4)));
constexpr int BM = 256, BK = 64, HALF = 128, HTB = HALF * BK * 2  , STAGE_BYTES = 8 * HTB, NXCD = 8, WGM = 8;

__host__ __device__ __forceinline__ int lds_byte(int r, int c) { const int st = (r >> 4) * 2 + (c >> 5), rr = r & 15, cc = c & 31, ob = rr * 64 + cc * 2; return st * 1024 + (ob ^ (((ob >> 9) & 1) << 5)); }
__host__ __device__ __forceinline__ void stage_rc(int b, int& R, int& C) { const int st = b / 1024, sb = b % 1024, swz = sb ^ (((sb >> 9) & 1) << 5); R = (st >> 1) * 16 + swz / 64; C = (st & 1) * 32 + (swz % 64) / 2; }
__host__ __device__ __forceinline__ int perm32(int rho) { const int n = rho >> 4, i = rho & 15; return 8 * (i >> 2) + 4 * n + (i & 3); }

struct Unit { int pm, pn, kb; };
struct Gemm { const bf16_t* A; const bf16_t* Bt; int M, N, K, ld; };

struct StaticOrder {
    int nM, nN, nwg, G, c;
    __host__ __device__ void init(int M, int N, int G_, int c_) { nM = M / BM; nN = N / BM; nwg = nM * nN; G = G_; c = c_; }
    __host__ __device__ bool next(int i, Unit& u) const {
        const long L = (long)i * G + c; if (L >= nwg) return false;
        int wgid = (int)L; { const int q = nwg / NXCD, r = nwg % NXCD, xcd = wgid % NXCD, off = wgid / NXCD; wgid = (xcd < r ? xcd * (q + 1) : r * (q + 1) + (xcd - r) * q) + off; }
        const int nig = WGM * nN, gid = wgid / nig, fm = gid * WGM, gsz = (nM - fm) < WGM ? (nM - fm) : WGM;
        u.pm = fm + ((wgid % nig) % gsz); u.pn = (wgid % nig) / gsz; u.kb = 0; return true;
    }
    __device__ __forceinline__ void a_ready(const Unit&) const {}
    __device__ __forceinline__ void done(const Unit&) const {}
};


__device__ __forceinline__ unsigned cvt_pk_bf16(float lo, float hi) { unsigned r; asm volatile("v_cvt_pk_bf16_f32 %0, %1, %2" : "=v"(r) : "v"(lo), "v"(hi)); return r; }
constexpr int NLAT = 32768;
constexpr float QSCALE = 0.17677669529663687f * 1.4426950408889634f;

struct EpiZ {
    static constexpr bool PERM = true, AFTER_DRAIN = false;
    bf16_t* Z; const float* rc; const float* rs;
    bf16_t* KC; bf16_t* VC;
    __device__ __forceinline__ void operator()(const f32x4 (&acc)[2][2][4][2], const Unit& u, int wr, int wc, int fr, int fq) const {
        const int row0 = u.pm * BM + wr * 64 + fr, col0 = u.pn * BM + wc * 32 + 8 * fq;
        const bool isq = (u.pn == 2), isk = (u.pn == 3), dorope = (u.pm < NLAT / BM) && (isq || isk);
        const float qs = isq ? QSCALE : 1.f;
#pragma unroll
        for (int ai = 0; ai < 2; ++ai)
#pragma unroll
            for (int m = 0; m < 4; ++m) {
                const int row = row0 + ai * HALF + m * 16;
                f32x4 c0 = {1.f, 1.f, 1.f, 1.f}, c1 = c0, s0 = {0.f, 0.f, 0.f, 0.f}, s1 = s0;
                if (dorope) { const int t = row & 8191, pos = (fq >> 1) ? (t & 63) : (t >> 6);
                    c0 = *(const f32x4*)(rc + pos * 8); c1 = *(const f32x4*)(rc + pos * 8 + 4); s0 = *(const f32x4*)(rs + pos * 8); s1 = *(const f32x4*)(rs + pos * 8 + 4);
                    if (!(fq & 1)) { s0 = -s0; s1 = -s1; } }
                bf16_t* rowp = Z + (size_t)row * 2560 + col0; size_t bjstep = HALF;
                if (u.pn == 3 || u.pn == 4) { const bool lt = row < NLAT; const int bb_ = lt ? (row >> 13) : ((row - NLAT) >> 8), key = lt ? 256 + (row & 8191) : ((row - NLAT) & 255);
                    const int cw = wc * 32 + 8 * fq;
                    rowp = (u.pn == 3 ? KC : VC) + ((size_t)(bb_ * 4 + (cw >> 6)) * 8448 + key) * 64 + (cw & 63); bjstep = (size_t)2 * 8448 * 64; }
#pragma unroll
                for (int bj = 0; bj < 2; ++bj) {
                    f32x4 v0 = acc[ai][bj][m][0], v1 = acc[ai][bj][m][1];
                    if (dorope) {
                        f32x4 p0, p1;
#pragma unroll
                        for (int i = 0; i < 4; ++i) { p0[i] = __shfl_xor(v0[i], 16); p1[i] = __shfl_xor(v1[i], 16); }
                        v0 = v0 * c0 + p0 * s0; v1 = v1 * c1 + p1 * s1;
                    }
                    v0 = v0 * qs; v1 = v1 * qs;
                    u32x4 w; w.x = cvt_pk_bf16(v0[0], v0[1]); w.y = cvt_pk_bf16(v0[2], v0[3]); w.z = cvt_pk_bf16(v1[0], v1[1]); w.w = cvt_pk_bf16(v1[2], v1[3]);
                    *(u32x4*)(rowp + bj * bjstep) = w;
                }
            }
    }
};
struct EpiRelu2 {
    static constexpr bool PERM = true, AFTER_DRAIN = false;
    bf16_t* H;
    __device__ __forceinline__ void operator()(const f32x4 (&acc)[2][2][4][2], const Unit& u, int wr, int wc, int fr, int fq) const {
        const int row0 = u.pm * BM + wr * 64 + fr, col0 = u.pn * BM + wc * 32 + 8 * fq;
#pragma unroll
        for (int ai = 0; ai < 2; ++ai)
#pragma unroll
            for (int m = 0; m < 4; ++m) {
                bf16_t* rowp = H + (size_t)(row0 + ai * HALF + m * 16) * 4096 + col0;
#pragma unroll
                for (int bj = 0; bj < 2; ++bj) {
                    f32x4 v0 = acc[ai][bj][m][0], v1 = acc[ai][bj][m][1];
#pragma unroll
                    for (int i = 0; i < 4; ++i) { const float a = fmaxf(v0[i], 0.f), b = fmaxf(v1[i], 0.f); v0[i] = a * a; v1[i] = b * b; }
                    u32x4 w; w.x = cvt_pk_bf16(v0[0], v0[1]); w.y = cvt_pk_bf16(v0[2], v0[3]); w.z = cvt_pk_bf16(v1[0], v1[1]); w.w = cvt_pk_bf16(v1[2], v1[3]);
                    *(u32x4*)(rowp + bj * HALF) = w;
                }
            }
    }
};
struct EpiRes {
    static constexpr bool PERM = true, AFTER_DRAIN = false;
    const float* baseLf; const bf16_t* baseLb; const float* baseC; bf16_t* outL; float* outC; const float* gate;
    __device__ __forceinline__ void operator()(const f32x4 (&acc)[2][2][4][2], const Unit& u, int wr, int wc, int fr, int fq) const {
        const bool lat = u.pm < NLAT / BM; const int bb = lat ? (u.pm >> 5) : 4;
        const int row0 = (lat ? u.pm * BM : u.pm * BM - NLAT) + wr * 64 + fr, col0 = u.pn * BM + wc * 32 + 8 * fq;
        f32x4 g[2][2];
#pragma unroll
        for (int bj = 0; bj < 2; ++bj)
#pragma unroll
            for (int n = 0; n < 2; ++n) g[bj][n] = *(const f32x4*)(gate + bb * 6144 + col0 + bj * HALF + n * 4);
#pragma unroll
        for (int ai = 0; ai < 2; ++ai)
#pragma unroll
            for (int m = 0; m < 4; ++m) {
                const size_t off = (size_t)(row0 + ai * HALF + m * 16) * 1024 + col0;
#pragma unroll
                for (int bj = 0; bj < 2; ++bj) {
                    f32x4 b0, b1;
                    if (!lat) { b0 = *(const f32x4*)(baseC + off + bj * HALF); b1 = *(const f32x4*)(baseC + off + bj * HALF + 4); }
                    else if (baseLf) { b0 = *(const f32x4*)(baseLf + off + bj * HALF); b1 = *(const f32x4*)(baseLf + off + bj * HALF + 4); }
                    else { const u32x4 w = *(const u32x4*)(baseLb + off + bj * HALF);
                        b0 = (f32x4){__builtin_bit_cast(float, w.x << 16), __builtin_bit_cast(float, w.x & 0xffff0000u), __builtin_bit_cast(float, w.y << 16), __builtin_bit_cast(float, w.y & 0xffff0000u)};
                        b1 = (f32x4){__builtin_bit_cast(float, w.z << 16), __builtin_bit_cast(float, w.z & 0xffff0000u), __builtin_bit_cast(float, w.w << 16), __builtin_bit_cast(float, w.w & 0xffff0000u)}; }
                    const f32x4 o0 = b0 + g[bj][0] * acc[ai][bj][m][0], o1 = b1 + g[bj][1] * acc[ai][bj][m][1];
                    if (!lat) { *(f32x4*)(outC + off + bj * HALF) = o0; *(f32x4*)(outC + off + bj * HALF + 4) = o1; }
                    else { u32x4 w; w.x = cvt_pk_bf16(o0.x, o0.y); w.y = cvt_pk_bf16(o0.z, o0.w); w.z = cvt_pk_bf16(o1.x, o1.y); w.w = cvt_pk_bf16(o1.z, o1.w); *(u32x4*)(outL + off + bj * HALF) = w; }
                }
            }
    }
};

struct CtxSplitOrder {
    int G, c;
    __device__ bool next(int i, Unit& u) const { const int L = i * G + c; if (L >= 64) return false; u.pm = NLAT / BM + (L & 3); u.pn = (L >> 2) & 3; u.kb = (L >> 4) * 1024 * 2; return true; }
    __device__ __forceinline__ void a_ready(const Unit&) const {}
    __device__ __forceinline__ void done(const Unit&) const {}
};
struct EpiResAtomicCtx {
    static constexpr bool PERM = false, AFTER_DRAIN = false;
    float* outC; const float* gate;
    __device__ __forceinline__ void operator()(const f32x4 (&acc)[2][2][4][2], const Unit& u, int wr, int wc, int fr, int fq) const {
        const int row0 = u.pm * BM - NLAT + wr * 64 + fr, col0 = u.pn * BM + wc * 32 + 4 * fq;
#pragma unroll
        for (int bj = 0; bj < 2; ++bj)
#pragma unroll
            for (int n = 0; n < 2; ++n) { const f32x4 g = *(const f32x4*)(gate + 4 * 6144 + col0 + bj * HALF + n * 16);
#pragma unroll
                for (int ai = 0; ai < 2; ++ai)
#pragma unroll
                    for (int m = 0; m < 4; ++m) { float* p = outC + (size_t)(row0 + ai * HALF + m * 16) * 1024 + col0 + bj * HALF + n * 16; const f32x4 v = g * acc[ai][bj][m][n];
#pragma unroll
                        for (int i = 0; i < 4; ++i) __hip_atomic_fetch_add(p + i, v[i], __ATOMIC_RELAXED, __HIP_MEMORY_SCOPE_AGENT); } }
    }
};
template <class Epi, class Sched, bool ALIGN_EPI = false, bool SP2 = false>
__device__ __forceinline__ void gemm_phase(PG8_LAS unsigned char* lds, const Gemm g, const Sched& S, const Epi& E) {
    int tid_ = threadIdx.x; asm volatile("" : "+v"(tid_)); const int tid = tid_, wid = __builtin_amdgcn_readfirstlane(tid >> 6), lane = tid & 63, wr = wid >> 2, wc = wid & 3, fr = lane & 15, fq = lane >> 4;
    const int K = g.K, nt = K / BK;
    unsigned voffA[2], voffB[2];
#pragma unroll
    for (int i = 0; i < 2; ++i) { int R, C; stage_rc(tid * 16 + i * 8192, R, C); const int Rb = Epi::PERM ? ((R & ~31) + perm32(R & 31)) : R;
        voffA[i] = (unsigned)(R * g.ld + C) * 2u; voffB[i] = (unsigned)(Rb * g.ld + C) * 2u; }
    const size_t kstep = (size_t)(BK * 2);
    const size_t hstep = (size_t)HALF * g.ld * 2;
    const size_t tstep = 2 * hstep;
    const unsigned ldsw = (unsigned)wid * 1024u;
    const int aoff = lds_byte(wr * 64 + fr, fq * 8), boff = lds_byte(wc * 32 + fr, fq * 8);
#define PG8_SA(b, h) (((b) * 2 + (h)) * HTB)
#define PG8_SB(b, h) ((4 + (b) * 2 + (h)) * HTB)
#define PG8_STAGE(bufoff, gbase, voff) do { _Pragma("unroll") for (int _i = 0; _i < 2; ++_i) \
        __builtin_amdgcn_global_load_lds((const unsigned*)((const char*)(gbase) + (voff)[_i]), (PG8_LAS unsigned*)(lds + (bufoff) + ldsw + _i * 8192), 16, 0, 0); } while (0)
#define PG8_LDA(dst, b, h) do { _Pragma("unroll") for (int m = 0; m < 4; ++m) _Pragma("unroll") for (int k = 0; k < 2; ++k) dst[m][k] = *(const PG8_LAS bf16x8*)(lds + PG8_SA(b, h) + aoff + m * 2048 + k * 1024); } while (0)
#define PG8_LDB(dst, b, h) do { _Pragma("unroll") for (int n = 0; n < 2; ++n) _Pragma("unroll") for (int k = 0; k < 2; ++k) dst[n][k] = *(const PG8_LAS bf16x8*)(lds + PG8_SB(b, h) + boff + n * 2048 + k * 1024); } while (0)
#define PG8_MMA(ai, bj, At, Bt) do { __builtin_amdgcn_s_setprio(1); _Pragma("unroll") for (int m = 0; m < 4; ++m) _Pragma("unroll") for (int n = 0; n < 2; ++n) _Pragma("unroll") for (int k = 0; k < 2; ++k) \
        acc[ai][bj][m][n] = __builtin_amdgcn_mfma_f32_16x16x32_bf16(Bt[n][k], At[m][k], acc[ai][bj][m][n], 0, 0, 0); __builtin_amdgcn_s_setprio(0); } while (0)
#define PG8_WAIT_V(n) asm volatile("s_waitcnt vmcnt(" #n ")" ::: "memory")
#define PG8_WAIT_L(n) asm volatile("s_waitcnt lgkmcnt(" #n ")" ::: "memory")
#define PG8_BAR __builtin_amdgcn_s_barrier()
#define PG8_SCHED __builtin_amdgcn_sched_barrier(0)
    Unit cur, nxt; int ui = 0;
    if (!S.next(0, cur)) return;
    f32x4 acc[2][2][4][2];
#pragma unroll
    for (int a = 0; a < 2; ++a)
#pragma unroll
        for (int b = 0; b < 2; ++b)
#pragma unroll
            for (int m = 0; m < 4; ++m)
#pragma unroll
                for (int n = 0; n < 2; ++n) acc[a][b][m][n] = (f32x4){0.f, 0.f, 0.f, 0.f};
    bf16x8 At[4][2], B0[2][2], B1[2][2];
    const char* cA = (const char*)g.A + (size_t)cur.pm * tstep + cur.kb; const char* cB = (const char*)g.Bt + (size_t)cur.pn * tstep + cur.kb;
    S.a_ready(cur);
    if constexpr (SP2) {
        PG8_STAGE(PG8_SB(0, 0), cB, voffB); PG8_STAGE(PG8_SB(0, 1), cB + hstep, voffB); PG8_STAGE(PG8_SA(0, 0), cA, voffA); PG8_STAGE(PG8_SA(0, 1), cA + hstep, voffA);
        if (wr == 1) PG8_BAR;
        PG8_WAIT_V(2); PG8_BAR;
        PG8_STAGE(PG8_SB(1, 0), cB + kstep, voffB); PG8_STAGE(PG8_SA(1, 0), cA + kstep, voffA); PG8_STAGE(PG8_SB(1, 1), cB + hstep + kstep, voffB);
        PG8_WAIT_V(6); PG8_BAR;
    } else {
        PG8_STAGE(PG8_SB(0, 0), cB, voffB); PG8_STAGE(PG8_SA(0, 0), cA, voffA); PG8_STAGE(PG8_SB(0, 1), cB + hstep, voffB); PG8_STAGE(PG8_SA(0, 1), cA + hstep, voffA);
        if (wr == 1) PG8_BAR;
        PG8_WAIT_V(4); PG8_BAR;
        PG8_STAGE(PG8_SB(1, 0), cB + kstep, voffB); PG8_STAGE(PG8_SA(1, 0), cA + kstep, voffA); PG8_STAGE(PG8_SB(1, 1), cB + hstep + kstep, voffB);
        PG8_WAIT_V(6); PG8_BAR;
    }
    for (;;) {
        const bool has_next = S.next(ui + 1, nxt);
        const char* nA = has_next ? (const char*)g.A + (size_t)nxt.pm * tstep + nxt.kb : cA; const char* nB = has_next ? (const char*)g.Bt + (size_t)nxt.pn * tstep + nxt.kb : cB;
        for (int t = 0; t < nt; t += 2) {
            const bool last = (t == nt - 2);
            const char* a1 = cA + (size_t)(t + 1) * kstep;
            const char* a2 = last ? nA : cA + (size_t)(t + 2) * kstep; const char* b2 = last ? nB : cB + (size_t)(t + 2) * kstep;
            const char* a3 = a2 + kstep; const char* b3 = b2 + kstep;
            if (last && has_next) S.a_ready(nxt);
            if constexpr (SP2) {
            PG8_LDB(B0, 0, 0); PG8_LDB(B1, 0, 1); PG8_SCHED; PG8_LDA(At, 0, 0); PG8_STAGE(PG8_SA(1, 1), a1 + hstep, voffA);
            PG8_WAIT_V(8); PG8_WAIT_L(0); PG8_BAR; PG8_MMA(0, 0, At, B0); PG8_MMA(0, 1, At, B1); PG8_BAR; PG8_SCHED;
            PG8_LDA(At, 0, 1); PG8_STAGE(PG8_SB(0, 0), b2, voffB); PG8_STAGE(PG8_SB(0, 1), b2 + hstep, voffB); PG8_STAGE(PG8_SA(0, 0), a2, voffA);
            PG8_WAIT_V(8); PG8_WAIT_L(0); PG8_BAR; PG8_MMA(1, 0, At, B0); PG8_MMA(1, 1, At, B1); PG8_BAR; PG8_SCHED;
            PG8_LDB(B0, 1, 0); PG8_LDB(B1, 1, 1); PG8_SCHED; PG8_LDA(At, 1, 0); PG8_STAGE(PG8_SA(0, 1), a2 + hstep, voffA);
            PG8_WAIT_V(8); PG8_WAIT_L(0); PG8_BAR; PG8_MMA(0, 0, At, B0); PG8_MMA(0, 1, At, B1); PG8_BAR; PG8_SCHED;
            PG8_LDA(At, 1, 1); PG8_STAGE(PG8_SB(1, 0), b3, voffB); PG8_STAGE(PG8_SB(1, 1), b3 + hstep, voffB); PG8_STAGE(PG8_SA(1, 0), a3, voffA);
            PG8_WAIT_V(8); PG8_WAIT_L(0); PG8_BAR; PG8_MMA(1, 0, At, B0); PG8_MMA(1, 1, At, B1); PG8_BAR; PG8_SCHED;
            } else {
            PG8_LDB(B0, 0, 0); PG8_SCHED; PG8_LDA(At, 0, 0); PG8_STAGE(PG8_SA(1, 1), a1 + hstep, voffA);
            PG8_WAIT_L(8); PG8_BAR; PG8_WAIT_L(0); PG8_MMA(0, 0, At, B0); PG8_BAR; PG8_SCHED;
            PG8_LDB(B1, 0, 1); PG8_STAGE(PG8_SB(0, 0), b2, voffB);
            PG8_BAR; PG8_WAIT_L(0); PG8_MMA(0, 1, At, B1); PG8_BAR;
            PG8_LDA(At, 0, 1); PG8_STAGE(PG8_SA(0, 0), a2, voffA);
            PG8_BAR; PG8_WAIT_L(0); PG8_MMA(1, 0, At, B0); PG8_BAR; PG8_SCHED;
            PG8_STAGE(PG8_SB(0, 1), b2 + hstep, voffB);
            PG8_WAIT_V(6); PG8_BAR; PG8_MMA(1, 1, At, B1); PG8_BAR;
            PG8_LDB(B0, 1, 0); PG8_SCHED; PG8_LDA(At, 1, 0); PG8_STAGE(PG8_SA(0, 1), a2 + hstep, voffA);
            PG8_WAIT_L(8); PG8_BAR; PG8_WAIT_L(0); PG8_MMA(0, 0, At, B0); PG8_BAR; PG8_SCHED;
            PG8_LDB(B1, 1, 1); PG8_STAGE(PG8_SB(1, 0), b3, voffB);
            PG8_BAR; PG8_WAIT_L(0); PG8_MMA(0, 1, At, B1); PG8_BAR;
            PG8_LDA(At, 1, 1); PG8_STAGE(PG8_SA(1, 0), a3, voffA);
            PG8_BAR; PG8_WAIT_L(0); PG8_MMA(1, 0, At, B0); PG8_BAR; PG8_SCHED;
            PG8_STAGE(PG8_SB(1, 1), b3 + hstep, voffB);
            PG8_WAIT_V(6); PG8_BAR; PG8_MMA(1, 1, At, B1); PG8_BAR;
            }
        }
        if constexpr (ALIGN_EPI) { if (wr == 0) PG8_BAR; }
        if constexpr (!Epi::AFTER_DRAIN) { E(acc, cur, wr, wc, fr, fq); S.done(cur); }
        if (!has_next) break;
#pragma unroll
        for (int a = 0; a < 2; ++a)
#pragma unroll
            for (int b = 0; b < 2; ++b)
#pragma unroll
                for (int m = 0; m < 4; ++m)
#pragma unroll
                    for (int n = 0; n < 2; ++n) acc[a][b][m][n] = (f32x4){0.f, 0.f, 0.f, 0.f};
        cur = nxt; cA = nA; cB = nB; ++ui;
        if constexpr (ALIGN_EPI) { if (wr == 1) PG8_BAR; }
    }
    PG8_WAIT_V(0);
    if constexpr (!ALIGN_EPI) { if (wr == 0) PG8_BAR; }
    PG8_BAR;
    if constexpr (Epi::AFTER_DRAIN) { E.fused(acc, cur, wr, wc, fr, fq, lds, wid, lane); S.done(cur); }
#undef PG8_SA
#undef PG8_SB
#undef PG8_STAGE
#undef PG8_LDA
#undef PG8_LDB
#undef PG8_MMA
#undef PG8_WAIT_V
#undef PG8_WAIT_L
#undef PG8_BAR
#undef PG8_SCHED
}
}

#ifndef PROBE_ATT
#define PROBE_ATT 1
#endif
#ifndef PROBE_VAR
#define PROBE_VAR 0
#endif
#ifndef PROBE_LIGHT
#define PROBE_LIGHT 1
#endif
#define LAS __attribute__((address_space(3)))
__device__ __forceinline__ int opaque_tid() { int t = threadIdx.x; asm volatile("" : "+v"(t)); return t; }
typedef unsigned short bf16;
typedef float f32x4 __attribute__((ext_vector_type(4)));
typedef float f32x16 __attribute__((ext_vector_type(16)));
typedef short bf16x8 __attribute__((ext_vector_type(8)));
typedef short s16x4 __attribute__((ext_vector_type(4)));
typedef unsigned u32x4 __attribute__((ext_vector_type(4)));
typedef unsigned u32x2 __attribute__((ext_vector_type(2)));

constexpr int DM = 1024, NB = 4, SEQ = 8192, NCTX = 256, NLAT = NB * SEQ, NROWS = NLAT + NB * NCTX;
constexpr int DIN = 2560, DFF = 4096;
constexpr size_t MiB = 1u << 20;
constexpr size_t WS_WIN = 1 * MiB, WS_WOUT = 11 * MiB, WS_W1 = 15 * MiB, WS_W2 = 31 * MiB, WS_SGW = 47 * MiB, WS_MOD = WS_SGW + 512 * 1024, WS_ROPE = WS_MOD + 256 * 1024;
constexpr size_t WS_XC = 48 * MiB, WS_XN = 52 * MiB, WS_H = 118 * MiB, WS_Z = WS_H, WS_Y = WS_H + 165 * MiB, WS_END = WS_H + 264 * MiB;
constexpr size_t WS_KC = 448 * MiB, WS_VC = 466 * MiB;
constexpr size_t WS_XB = 384 * MiB;
constexpr int LDS_BYTES = 131072 + 1024;
constexpr int NPHASE = 16;

struct Args {
    const float *x, *c, *ctx, *c_ctx, *ada_w, *ada_b, *norm1_g, *norm2_g, *w_in, *conv_a_w, *conv_a_b, *ln_a_g, *ln_a_b, *lam_q1, *lam_k1, *lam_q2, *lam_k2,
        *subln_g, *sg_ln_g, *sg_ln_b, *sg_w, *sg_b, *conv_d_w, *w_out, *mlp_w1, *mlp_w2, *final_g;
    float* out; unsigned char* ws; int ph_lo, ph_hi;
};

__device__ __forceinline__ unsigned f2bf(float f) { unsigned u = __builtin_bit_cast(unsigned, f); return (u + 0x7fffu + ((u >> 16) & 1u)) >> 16; }
__device__ __forceinline__ unsigned pk2(float lo, float hi) { return pg8::cvt_pk_bf16(lo, hi); }
__device__ __forceinline__ float bf2f(unsigned short v) { return __builtin_bit_cast(float, (unsigned)v << 16); }
__device__ __forceinline__ float bflo(unsigned w) { return __builtin_bit_cast(float, w << 16); }
__device__ __forceinline__ float bfhi(unsigned w) { return __builtin_bit_cast(float, w & 0xffff0000u); }
template <int CTRL> __device__ __forceinline__ float dppmov(float v) { return __builtin_bit_cast(float, __builtin_amdgcn_update_dpp(0, __builtin_bit_cast(int, v), CTRL, 0xf, 0xf, true)); }
__device__ __forceinline__ float sum8(float v) { v += dppmov<0xB1>(v); v += dppmov<0x4E>(v); v += dppmov<0x141>(v); return v; }
__device__ __forceinline__ float sum16(float v) { v = sum8(v); v += dppmov<0x140>(v); return v; }
__device__ __forceinline__ float sum32(float v) { v = sum16(v); auto r = __builtin_amdgcn_permlane16_swap(__float_as_uint(v), __float_as_uint(v), false, false); return __uint_as_float(r[0]) + __uint_as_float(r[1]); }
__device__ __forceinline__ float wave_sum(float v) { v = sum32(v); auto r = __builtin_amdgcn_permlane32_swap(__float_as_uint(v), __float_as_uint(v), false, false); return __uint_as_float(r[0]) + __uint_as_float(r[1]); }
__device__ __forceinline__ float sigmoidf_(float x) { return __builtin_amdgcn_rcpf(1.f + __builtin_amdgcn_exp2f(-1.4426950408889634f * x)); }
__device__ __forceinline__ float gelu_tanh(float x) { const float y2 = 2.302208198144325f * (x + 0.044715f * x * x * x);
    const float t = 1.f - 2.f * __builtin_amdgcn_rcpf(__builtin_amdgcn_exp2f(y2) + 1.f); return 0.5f * x * (1.f + t); }

__device__ __forceinline__ void p0_transpose_item(const float* W, int K, int N, bf16* WT, LAS float* scr, int item, int lane) {
    const int nblk = N / 32, kb = item / nblk, nb = item % nblk, k0 = 64 * kb, n0 = 32 * nb;
#pragma unroll
    for (int i = 0; i < 32; ++i) { const int kk = 2 * i + (lane >> 5); scr[kk * 33 + (lane & 31)] = W[(size_t)(k0 + kk) * N + n0 + (lane & 31)]; }
    asm volatile("s_waitcnt lgkmcnt(0)" ::: "memory");
    const int c = lane & 7;
#pragma unroll
    for (int j = 0; j < 4; ++j) { const int n = (lane >> 3) + 8 * j; const LAS float* s = scr + (8 * c) * 33 + n;
        u32x4 o; o.x = pk2(s[0 * 33], s[1 * 33]); o.y = pk2(s[2 * 33], s[3 * 33]); o.z = pk2(s[4 * 33], s[5 * 33]); o.w = pk2(s[6 * 33], s[7 * 33]);
        *(u32x4*)(WT + (size_t)(n0 + n) * K + k0 + 8 * c) = o; }
    asm volatile("s_waitcnt lgkmcnt(0)" ::: "memory");
}

__device__ __forceinline__ void phase_prologue(const Args& a, LAS unsigned char* lds, int G) {
    const int tid = opaque_tid(), lane = tid & 63, wave = tid >> 6, blk = blockIdx.x;
    unsigned char* ws = a.ws;
    {
        LAS float* S = (LAS float*)lds;
        LAS float* R = (LAS float*)(lds + 20480);
        float* mod = (float*)(ws + WS_MOD);
        bool have = false;
        for (int u = blk; u < 192; u += G) {
            if (!have) { for (int i = tid; i < 5120; i += 512) { const int bb = i >> 10, k = i & 1023; const float v = bb < 4 ? a.c[bb * 1024 + k] : a.c_ctx[k]; S[i] = v * sigmoidf_(v); } __syncthreads(); have = true; }
            const int l = u / 96, col = (u % 96) * 64 + lane;
            const float* W = a.ada_w + (size_t)l * 1024 * 6144 + col;
            float acc[5] = {0.f, 0.f, 0.f, 0.f, 0.f};
#pragma unroll 32
            for (int k = wave * 128; k < wave * 128 + 128; ++k) { const float w = W[(size_t)k * 6144];
#pragma unroll
                for (int bb = 0; bb < 5; ++bb) acc[bb] += S[bb * 1024 + k] * w; }
#pragma unroll
            for (int bb = 0; bb < 5; ++bb) R[(wave * 5 + bb) * 64 + lane] = acc[bb];
            __syncthreads();
            if (tid < 320) { const int bb = tid >> 6; float s = a.ada_b[l * 6144 + col];
#pragma unroll
                for (int w = 0; w < 8; ++w) s += R[(w * 5 + bb) * 64 + lane];
                mod[(size_t)(l * 5 + bb) * 6144 + col] = s; }
            __syncthreads();
        }
        __syncthreads();
    }
    const int gw = blk * 8 + wave, NGW = G * 8;
    {
        LAS float* scr = (LAS float*)(lds + wave * 16384);
        constexpr int I_IN = (DM / 64) * (DIN / 32), I_OUT = (DM / 64) * (DM / 32), I_1 = (DM / 64) * (DFF / 32), I_2 = (DFF / 64) * (DM / 32), I_L = I_IN + I_OUT + I_1 + I_2;
        for (int it = gw; it < 2 * I_L; it += NGW) {
            const int l = it / I_L; int r = it % I_L;
            if (r < I_IN) { p0_transpose_item(a.w_in + (size_t)l * DM * DIN, DM, DIN, (bf16*)(ws + WS_WIN) + (size_t)l * DIN * DM, scr, r, lane); continue; } r -= I_IN;
            if (r < I_OUT) { p0_transpose_item(a.w_out + (size_t)l * DM * DM, DM, DM, (bf16*)(ws + WS_WOUT) + (size_t)l * DM * DM, scr, r, lane); continue; } r -= I_OUT;
            if (r < I_1) { p0_transpose_item(a.mlp_w1 + (size_t)l * DM * DFF, DM, DFF, (bf16*)(ws + WS_W1) + (size_t)l * DFF * DM, scr, r, lane); continue; } r -= I_1;
            p0_transpose_item(a.mlp_w2 + (size_t)l * DFF * DM, DFF, DM, (bf16*)(ws + WS_W2) + (size_t)l * DM * DFF, scr, r, lane);
        }
    }
    {
        const int gt = blk * 512 + tid, NT = G * 512;
        bf16* sgw = (bf16*)(ws + WS_SGW);
        for (int i = gt; i < 2 * 4 * 128 * 128 / 2; i += NT) ((unsigned*)sgw)[i] = pk2(a.sg_w[2 * i], a.sg_w[2 * i + 1]);
        float* rc = (float*)(ws + WS_ROPE); float* rs = rc + 1024;
        if (gt < 1024) { const int pos = gt >> 3, j = gt & 7; const float inv = powf(10000.f, -(float)j / 8.f); const float ang = (float)pos * inv; rc[gt] = cosf(ang); rs[gt] = sinf(ang); }
    }
}

__device__ __forceinline__ void ldrow16(const float* XLf, const bf16* XLb, const float* XC, int r, int lane, f32x4 (&v)[4]) {
    if (r >= NLAT) { const f32x4* p = (const f32x4*)(XC + (size_t)(r - NLAT) * DM) + lane;
#pragma unroll
        for (int j = 0; j < 4; ++j) v[j] = p[64 * j]; }
    else if (XLf) { const f32x4* p = (const f32x4*)(XLf + (size_t)r * DM) + lane;
#pragma unroll
        for (int j = 0; j < 4; ++j) v[j] = p[64 * j]; }
    else { const u32x2* p = (const u32x2*)(XLb + (size_t)r * DM) + lane;
#pragma unroll
        for (int j = 0; j < 4; ++j) { const u32x2 w = p[64 * j]; v[j] = (f32x4){bflo(w.x), bfhi(w.x), bflo(w.y), bfhi(w.y)}; } }
}
__device__ __forceinline__ void phase_modnorm(const float* XLf, const bf16* XLb, const float* XC, bf16* XN, const float* g, const float* shift, const float* scale, int nrows, int G) {
    const int tid = opaque_tid(), lane = tid & 63, gw = blockIdx.x * 8 + (tid >> 6), NGW = G * 8;
    f32x4 gg[4];
#pragma unroll
    for (int j = 0; j < 4; ++j) gg[j] = *(const f32x4*)(g + 4 * (lane + 64 * j));
    for (int r0 = gw; r0 < nrows; r0 += 2 * NGW) {
        const int r1 = r0 + NGW; const bool two = r1 < nrows; const int r1c = two ? r1 : r0;
        const int bb0 = r0 < NLAT ? (r0 >> 13) : 4, bb1 = r1c < NLAT ? (r1c >> 13) : 4;
        f32x4 v[4], w[4], sc0[4], sh0[4], sc1[4], sh1[4]; float s0 = 0.f, s1 = 0.f;
        ldrow16(XLf, XLb, XC, r0, lane, v); ldrow16(XLf, XLb, XC, r1c, lane, w);
#pragma unroll
        for (int j = 0; j < 4; ++j) { const int c = 4 * (lane + 64 * j);
            sc0[j] = *(const f32x4*)(scale + bb0 * 6144 + c); sh0[j] = *(const f32x4*)(shift + bb0 * 6144 + c); sc1[j] = *(const f32x4*)(scale + bb1 * 6144 + c); sh1[j] = *(const f32x4*)(shift + bb1 * 6144 + c); }
#pragma unroll
        for (int j = 0; j < 4; ++j) { s0 += (v[j].x * v[j].x + v[j].y * v[j].y) + (v[j].z * v[j].z + v[j].w * v[j].w); s1 += (w[j].x * w[j].x + w[j].y * w[j].y) + (w[j].z * w[j].z + w[j].w * w[j].w); }
        const float rs0 = rsqrtf(wave_sum(s0) * (1.f / DM) + 1e-6f), rs1 = rsqrtf(wave_sum(s1) * (1.f / DM) + 1e-6f);
        u32x2* o0 = (u32x2*)(XN + (size_t)r0 * DM) + lane; u32x2* o1 = (u32x2*)(XN + (size_t)r1c * DM) + lane;
#pragma unroll
        for (int j = 0; j < 4; ++j) {
            { const f32x4 y = v[j] * rs0 * gg[j] * (sc0[j] + 1.f) + sh0[j]; u32x2 q; q.x = pk2(y.x, y.y); q.y = pk2(y.z, y.w); o0[64 * j] = q; }
            if (two) { const f32x4 y = w[j] * rs1 * gg[j] * (sc1[j] + 1.f) + sh1[j]; u32x2 q; q.x = pk2(y.x, y.y); q.y = pk2(y.z, y.w); o1[64 * j] = q; }
        }
    }
}
__device__ __forceinline__ void phase_finalnorm(const bf16* XB, float* out, const float* g, int G) {
    const int tid = opaque_tid(), lane = tid & 63, gw = blockIdx.x * 8 + (tid >> 6), NGW = G * 8;
    f32x4 gg[4];
#pragma unroll
    for (int j = 0; j < 4; ++j) gg[j] = *(const f32x4*)(g + 4 * (lane + 64 * j));
    for (int r0 = gw; r0 < NLAT; r0 += 2 * NGW) {
        const int r1 = r0 + NGW; const bool two = r1 < NLAT; const int r1c = two ? r1 : r0;
        f32x4 v[4], w[4]; float s0 = 0.f, s1 = 0.f;
        ldrow16(nullptr, XB, nullptr, r0, lane, v); ldrow16(nullptr, XB, nullptr, r1c, lane, w);
#pragma unroll
        for (int j = 0; j < 4; ++j) { s0 += (v[j].x * v[j].x + v[j].y * v[j].y) + (v[j].z * v[j].z + v[j].w * v[j].w); s1 += (w[j].x * w[j].x + w[j].y * w[j].y) + (w[j].z * w[j].z + w[j].w * w[j].w); }
        const float rs0 = rsqrtf(wave_sum(s0) * (1.f / DM) + 1e-6f), rs1 = rsqrtf(wave_sum(s1) * (1.f / DM) + 1e-6f);
        f32x4* o0 = (f32x4*)(out + (size_t)r0 * DM) + lane; f32x4* o1 = (f32x4*)(out + (size_t)r1c * DM) + lane;
#pragma unroll
        for (int j = 0; j < 4; ++j) { o0[64 * j] = v[j] * rs0 * gg[j]; if (two) o1[64 * j] = w[j] * rs1 * gg[j]; }
    }
}

__device__ __forceinline__ void ld8bf(const bf16* p, float (&o)[8]) {
    const u32x4 w = *(const u32x4*)p;
    o[0] = bflo(w.x); o[1] = bfhi(w.x); o[2] = bflo(w.y); o[3] = bfhi(w.y); o[4] = bflo(w.z); o[5] = bfhi(w.z); o[6] = bflo(w.w); o[7] = bfhi(w.w);
}
__device__ __forceinline__ u32x4 pk8(const float (&v)[8]) { u32x4 w; w.x = pk2(v[0], v[1]); w.y = pk2(v[2], v[3]); w.z = pk2(v[4], v[5]); w.w = pk2(v[6], v[7]); return w; }

__device__ __forceinline__ void conv_unit(const Args& a, int l, int tile, const bf16* Z, bf16* Y, LAS unsigned char* lds) {
    const int tid = opaque_tid(), lane = tid & 63, wave = tid >> 6;
    const int R0 = tile * 64; const bool lat = R0 < NLAT;
    const int seq0 = lat ? (R0 & ~(SEQ - 1)) : NLAT + ((R0 - NLAT) & ~(NCTX - 1)), seq1 = seq0 + (lat ? SEQ : NCTX);
    LAS unsigned short* Gl = (LAS unsigned short*)lds;
    LAS float* Yl = (LAS float*)(lds + 49152);
    {
        u32x4 rv[6], rg[6];
#pragma unroll
        for (int i = 0; i < 6; ++i) { const int it = tid + 512 * i, pr = it >> 5, ch = (it & 31) * 8, row = R0 - 15 + pr;
            rv[i] = (u32x4){0u, 0u, 0u, 0u}; rg[i] = rv[i];
            if (it < 94 * 32 && row >= seq0 && row < seq1) { rv[i] = *(const u32x4*)(Z + (size_t)row * DIN + ch); rg[i] = *(const u32x4*)(Z + (size_t)row * DIN + 256 + ch); } }
#pragma unroll
        for (int i = 0; i < 6; ++i) { const int it = tid + 512 * i, pr = it >> 5, ch = (it & 31) * 8;
            if (it < 94 * 32) {
                const float av[8] = {bflo(rv[i].x), bfhi(rv[i].x), bflo(rv[i].y), bfhi(rv[i].y), bflo(rv[i].z), bfhi(rv[i].z), bflo(rv[i].w), bfhi(rv[i].w)};
                const float ag[8] = {bflo(rg[i].x), bfhi(rg[i].x), bflo(rg[i].y), bfhi(rg[i].y), bflo(rg[i].z), bfhi(rg[i].z), bflo(rg[i].w), bfhi(rg[i].w)};
                float o[8];
#pragma unroll
                for (int j = 0; j < 8; ++j) o[j] = av[j] * sigmoidf_(ag[j]);
                *(LAS u32x4*)(Gl + pr * 256 + ch) = pk8(o); } }
    }
    const f32x4 lng = *(const f32x4*)(a.ln_a_g + l * 256 + 4 * lane), lnb = *(const f32x4*)(a.ln_a_b + l * 256 + 4 * lane);
    float w[31];
#pragma unroll
    for (int k = 0; k < 31; ++k) w[k] = a.conv_a_w[(size_t)l * 31 * 256 + k * 256 + (tid & 255)];
    const float bias = a.conv_a_b[l * 256 + (tid & 255)];
    __syncthreads();
    {
        const int c = tid & 255, ph = tid >> 8;
        float acc[32];
#pragma unroll
        for (int p = 0; p < 32; ++p) acc[p] = bias;
        const LAS unsigned short* gp = Gl + (ph * 32) * 256 + c;
        unsigned short graw[62];
#pragma unroll
        for (int j = 0; j < 62; ++j) graw[j] = gp[j * 256];
#pragma unroll
        for (int j = 0; j < 62; ++j) { const float g = bf2f(graw[j]);
#pragma unroll
            for (int p = 0; p < 32; ++p) { const int k = j - p; if (k >= 0 && k < 31) acc[p] += w[k] * g; } }
#pragma unroll
        for (int p = 0; p < 32; ++p) Yl[(ph * 32 + p) * 256 + c] = acc[p];
    }
    __syncthreads();
    {
        const f32x4 gg = lng, bb = lnb;
#pragma unroll
        for (int i = 0; i < 8; ++i) { const int p = wave * 8 + i;
            const f32x4 v = *(const LAS f32x4*)(Yl + p * 256 + 4 * lane);
            const float mean = wave_sum((v.x + v.y) + (v.z + v.w)) * (1.f / 256.f);
            const f32x4 d = v - mean;
            const float var = wave_sum((d.x * d.x + d.y * d.y) + (d.z * d.z + d.w * d.w)) * (1.f / 256.f);
            f32x4 y = d * rsqrtf(var + 1e-6f) * gg + bb;
            y.x *= sigmoidf_(y.x); y.y *= sigmoidf_(y.y); y.z *= sigmoidf_(y.z); y.w *= sigmoidf_(y.w);
            u32x2 o; o.x = pk2(y.x, y.y); o.y = pk2(y.z, y.w);
            *(u32x2*)(Y + (size_t)(R0 + p) * DM + 4 * lane) = o; }
    }
    {
        const int ch = (tid & 31) * 8;
        const f32x4 wa0 = *(const f32x4*)(a.conv_d_w + l * 768 + ch), wa1 = *(const f32x4*)(a.conv_d_w + l * 768 + ch + 4), wb0 = *(const f32x4*)(a.conv_d_w + l * 768 + 256 + ch), wb1 = *(const f32x4*)(a.conv_d_w + l * 768 + 256 + ch + 4),
                    wc0 = *(const f32x4*)(a.conv_d_w + l * 768 + 512 + ch), wc1 = *(const f32x4*)(a.conv_d_w + l * 768 + 512 + ch + 4);
        const float w0[8] = {wa0.x, wa0.y, wa0.z, wa0.w, wa1.x, wa1.y, wa1.z, wa1.w}, w1[8] = {wb0.x, wb0.y, wb0.z, wb0.w, wb1.x, wb1.y, wb1.z, wb1.w}, w2[8] = {wc0.x, wc0.y, wc0.z, wc0.w, wc1.x, wc1.y, wc1.z, wc1.w};
#pragma unroll
        for (int half = 0; half < 2; ++half) {
            u32x4 rb[2], c0[2], x0[2], cm[2], xm[2], cp[2], xp[2];
#pragma unroll
            for (int i = 0; i < 2; ++i) { const int row = R0 + (tid >> 5) + 16 * (2 * half + i); const bf16* zr = Z + (size_t)row * DIN + ch; const u32x4 z4 = {0u, 0u, 0u, 0u};
                rb[i] = *(const u32x4*)(zr + 1792); c0[i] = *(const u32x4*)(zr + 2048); x0[i] = *(const u32x4*)(zr + 2304);
                cm[i] = z4; xm[i] = z4; cp[i] = z4; xp[i] = z4;
                if (row - 1 >= seq0) { cm[i] = *(const u32x4*)(zr - DIN + 2048); xm[i] = *(const u32x4*)(zr - DIN + 2304); }
                if (row + 1 < seq1) { cp[i] = *(const u32x4*)(zr + DIN + 2048); xp[i] = *(const u32x4*)(zr + DIN + 2304); } }
#pragma unroll
            for (int i = 0; i < 2; ++i) { const int row = R0 + (tid >> 5) + 16 * (2 * half + i);
#define UNPK(V) {bflo(V.x), bfhi(V.x), bflo(V.y), bfhi(V.y), bflo(V.z), bfhi(V.z), bflo(V.w), bfhi(V.w)}
                const float bg[8] = UNPK(rb[i]), a0[8] = UNPK(c0[i]), b0[8] = UNPK(x0[i]), am[8] = UNPK(cm[i]), bm[8] = UNPK(xm[i]), ap[8] = UNPK(cp[i]), bp[8] = UNPK(xp[i]);
#undef UNPK
                float o[8];
#pragma unroll
                for (int j = 0; j < 8; ++j) o[j] = bg[j] * (w0[j] * (am[j] * bm[j]) + w1[j] * (a0[j] * b0[j]) + w2[j] * (ap[j] * bp[j]));
                *(u32x4*)(Y + (size_t)row * DM + 768 + ch) = pk8(o); }
        }
    }
    __syncthreads();
}

__device__ __forceinline__ int v_st(int k, int c) { const int kk = (k & ~0xC) | ((k & 4) << 1) | ((k & 8) >> 1); return ((kk >> 3) * 2 + (c >> 5)) * 512 + ((kk & 7) * 32 + (c & 31)) * 2; }
__device__ __forceinline__ int v_st_nat(int k, int c) { return ((k >> 3) * 2 + (c >> 5)) * 512 + ((k & 7) * 32 + (c & 31)) * 2; }
__device__ __forceinline__ int v_rd_base(int lane) { return ((lane & 3) << 3) | (((lane >> 2) & 3) << 6) | (((lane >> 4) & 1) << 5) | (((lane >> 5) & 1) << 8); }
constexpr int v_rd_off(int d0, int ks, int half) { return d0 * 512 + ks * 2048 + half * 1024; }
template <int OFF> __device__ __forceinline__ s16x4 tr_read(int vb) { s16x4 r; asm volatile("ds_read_b64_tr_b16 %0, %1 offset:%2" : "=&v"(r) : "v"(vb), "i"(OFF) : "memory"); return r; }
__device__ __forceinline__ int crow(int r, int hi) { return (r & 3) + 8 * (r >> 2) + 4 * hi; }
#define SBAR() __builtin_amdgcn_sched_barrier(0)
#define MFMA32(a, b, c) __builtin_amdgcn_mfma_f32_32x32x16_bf16((a), (b), (c), 0, 0, 0)
#define PKV(L, H) (bf16x8){L[0], L[1], L[2], L[3], H[0], H[1], H[2], H[3]}

__device__ __forceinline__ void sg_unit(const Args& a, int l, int chunk, const bf16* Z, bf16* Y, LAS unsigned char* lds) {
    const int tid = opaque_tid(), lane = tid & 63, wave = tid >> 6, r32 = lane & 31, hi = lane >> 5;
    const int R0 = chunk * 128;
    bf16x8 wa[8][2];
    { const bf16* Wg0 = (const bf16*)(a.ws + WS_SGW) + (size_t)(l * 4 + (wave >> 1)) * 128 * 128 + (size_t)(64 * (wave & 1) + r32) * 128 + 8 * hi;
#pragma unroll
      for (int ks = 0; ks < 8; ++ks) { wa[ks][0] = *(const bf16x8*)(Wg0 + 16 * ks); wa[ks][1] = *(const bf16x8*)(Wg0 + 32 * 128 + 16 * ks); } }
    {
        const int hw = tid >> 5;
        float gg[8], bb[8];
#pragma unroll
        for (int i = 0; i < 8; ++i) { gg[i] = a.sg_ln_g[l * 256 + 8 * r32 + i]; bb[i] = a.sg_ln_b[l * 256 + 8 * r32 + i]; }
        u32x4 raw[8];
#pragma unroll
        for (int i = 0; i < 8; ++i) raw[i] = *(const u32x4*)(Z + (size_t)(R0 + hw + 16 * i) * DIN + 1536 + 8 * r32);
#pragma unroll
        for (int ii = 0; ii < 8; ++ii) { const int pp = hw + 16 * ii;
            float v[8] = {bflo(raw[ii].x), bfhi(raw[ii].x), bflo(raw[ii].y), bfhi(raw[ii].y), bflo(raw[ii].z), bfhi(raw[ii].z), bflo(raw[ii].w), bfhi(raw[ii].w)};
            float s = 0.f;
#pragma unroll
            for (int i = 0; i < 8; ++i) { v[i] = gelu_tanh(v[i]); s += v[i]; }
            s = sum32(s);
            const float mean = s * (1.f / 256.f); float q = 0.f;
#pragma unroll
            for (int i = 0; i < 8; ++i) { v[i] -= mean; q += v[i] * v[i]; }
            q = sum32(q);
            const float rstd = rsqrtf(q * (1.f / 256.f) + 1e-6f);
#pragma unroll
            for (int i = 0; i < 8; ++i) v[i] = v[i] * rstd * gg[i] + bb[i];
            *(LAS u32x4*)(lds + (r32 >> 3) * 16384 + v_st(pp, (r32 & 7) * 8)) = pk8(v);
        }
    }
    __syncthreads();
    {
        const int g = wave >> 1, ph = wave & 1;
        const bf16* Wg = (const bf16*)(a.ws + WS_SGW) + (size_t)(l * 4 + g) * 128 * 128;
        const int vb = (int)(unsigned)(uintptr_t)(lds + g * 16384) + v_rd_base(lane);
        f32x16 acc[2][2];
#pragma unroll
        for (int i = 0; i < 2; ++i)
#pragma unroll
            for (int j = 0; j < 2; ++j) acc[i][j] = f32x16{};
#define SG_STEP(KS) do { \
            const bf16x8 a0 = wa[KS][0], a1 = wa[KS][1]; \
            const s16x4 l0 = tr_read<v_rd_off(0, KS, 0)>(vb), h0 = tr_read<v_rd_off(0, KS, 1)>(vb), l1 = tr_read<v_rd_off(1, KS, 0)>(vb), h1 = tr_read<v_rd_off(1, KS, 1)>(vb); \
            asm volatile("s_waitcnt lgkmcnt(0)" ::: "memory"); SBAR(); \
            acc[0][0] = MFMA32(a0, PKV(l0, h0), acc[0][0]); acc[0][1] = MFMA32(a0, PKV(l1, h1), acc[0][1]); \
            acc[1][0] = MFMA32(a1, PKV(l0, h0), acc[1][0]); acc[1][1] = MFMA32(a1, PKV(l1, h1), acc[1][1]); } while (0)
        SG_STEP(0); SG_STEP(1); SG_STEP(2); SG_STEP(3); SG_STEP(4); SG_STEP(5); SG_STEP(6); SG_STEP(7);
#undef SG_STEP
#pragma unroll
        for (int pb = 0; pb < 2; ++pb) {
            unsigned short uu[16][2]; float bsv[16];
#pragma unroll
            for (int r = 0; r < 16; ++r) { const int p = 64 * ph + 32 * pb + crow(r, hi); bsv[r] = a.sg_b[(l * 4 + g) * 128 + p];
                uu[r][0] = Z[(size_t)(R0 + p) * DIN + 1280 + g * 64 + r32]; uu[r][1] = Z[(size_t)(R0 + p) * DIN + 1280 + g * 64 + 32 + r32]; }
#pragma unroll
            for (int r = 0; r < 16; ++r) { const int p = 64 * ph + 32 * pb + crow(r, hi);
#pragma unroll
                for (int d0 = 0; d0 < 2; ++d0) { const int col = g * 64 + 32 * d0 + r32;
                    Y[(size_t)(R0 + p) * DM + 512 + col] = (bf16)f2bf(gelu_tanh(bf2f(uu[r][d0])) * (acc[pb][d0][r] + bsv[r])); } }
        }
    }
    __syncthreads();
}

constexpr int AT_K = 0, AT_KB = 128 * 144, AT_V = 2 * AT_KB, AT_VB = 16384, AT_WS = AT_V + 2 * AT_VB, AT_ST = AT_WS + 2048, AT_END = AT_ST + 4 * 8192;
static_assert(AT_END <= 131072, "attention LDS map");
constexpr float AT_THR = 8.f;
typedef float f32x2_t __attribute__((ext_vector_type(2))); typedef __bf16 bf16x2_t __attribute__((ext_vector_type(2)));
__device__ __forceinline__ unsigned cvtpk_s(float lo, float hi) { f32x2_t v = {lo, hi}; bf16x2_t b = __builtin_convertvector(v, bf16x2_t); return __builtin_bit_cast(unsigned, b); }
__device__ __forceinline__ float max3f(float a, float b, float c) { float r; asm("v_max3_f32 %0, %1, %2, %3" : "=v"(r) : "v"(a), "v"(b), "v"(c)); return r; }
__device__ __forceinline__ float max2f(float a, float b) { float r; asm("v_max_f32_e32 %0, %1, %2" : "=v"(r) : "v"(a), "v"(b)); return r; }
#define AT_SUBTILE(SUB, FIRST) do { \
    f32x16 p0 = MFMA32(k0, q0, negm); p0 = MFMA32(k1, q1, p0); \
    f32x16 p1 = MFMA32(k2, q0, negm); p1 = MFMA32(k3, q1, p1); \
    SBAR(); \
    const s16x4 va0 = tr_read<v_rd_off(0, SUB * 4 + 0, 0)>(vb), vb0_ = tr_read<v_rd_off(0, SUB * 4 + 0, 1)>(vb), va1 = tr_read<v_rd_off(0, SUB * 4 + 1, 0)>(vb), vb1_ = tr_read<v_rd_off(0, SUB * 4 + 1, 1)>(vb); \
    const s16x4 va2 = tr_read<v_rd_off(0, SUB * 4 + 2, 0)>(vb), vb2_ = tr_read<v_rd_off(0, SUB * 4 + 2, 1)>(vb), va3 = tr_read<v_rd_off(0, SUB * 4 + 3, 0)>(vb), vb3_ = tr_read<v_rd_off(0, SUB * 4 + 3, 1)>(vb); \
    const s16x4 wa0 = tr_read<v_rd_off(1, SUB * 4 + 0, 0)>(vb), wb0 = tr_read<v_rd_off(1, SUB * 4 + 0, 1)>(vb), wa1 = tr_read<v_rd_off(1, SUB * 4 + 1, 0)>(vb), wb1 = tr_read<v_rd_off(1, SUB * 4 + 1, 1)>(vb); \
    const s16x4 wa2 = tr_read<v_rd_off(1, SUB * 4 + 2, 0)>(vb), wb2 = tr_read<v_rd_off(1, SUB * 4 + 2, 1)>(vb), wa3 = tr_read<v_rd_off(1, SUB * 4 + 3, 0)>(vb), wb3 = tr_read<v_rd_off(1, SUB * 4 + 3, 1)>(vb); \
    if (SUB == 0) { k0 = *(const LAS bf16x8*)(kp + 64 * 144); k1 = *(const LAS bf16x8*)(kp + 64 * 144 + 32); k2 = *(const LAS bf16x8*)(kp + 96 * 144); k3 = *(const LAS bf16x8*)(kp + 96 * 144 + 32); } \
    SBAR(); \
    asm volatile("s_nop 15\n\ts_nop 7" : "+v"(p0), "+v"(p1)); \
    float ma = max3f(p0[0], p0[1], p1[0]), mb = max3f(p0[2], p0[3], p1[1]); ma = max3f(ma, p1[2], p1[3]); \
    _Pragma("unroll") for (int r = 4; r < 16; r += 4) { ma = max3f(ma, p0[r], p0[r + 1]); mb = max3f(mb, p0[r + 2], p0[r + 3]); ma = max3f(ma, p1[r], p1[r + 1]); mb = max3f(mb, p1[r + 2], p1[r + 3]); } \
    float rm = max2f(ma, mb); \
    { auto rr = __builtin_amdgcn_permlane32_swap(__float_as_uint(rm), __float_as_uint(rm), false, false); rm = max2f(__uint_as_float(rr[0]), __uint_as_float(rr[1])); } \
    if ((FIRST) || __any(rm > AT_THR)) { \
        const float dl = (FIRST) ? rm : max2f(rm, 0.f); \
        m += dl; \
        _Pragma("unroll") for (int r = 0; r < 16; ++r) { p0[r] -= dl; p1[r] -= dl; negm[r] = -m; } \
        if (!(FIRST)) { \
            const float f = __builtin_amdgcn_exp2f(-dl); \
            if (hi == 0) wsf[r32] = f; \
            asm volatile("s_waitcnt lgkmcnt(0)" ::: "memory"); \
            _Pragma("unroll") for (int r = 0; r < 16; ++r) { const float fr = wsf[crow(r, hi)]; o0[r] *= fr; o1[r] *= fr; lacc[r] *= fr; } \
        } \
    } \
    _Pragma("unroll") for (int r = 0; r < 16; ++r) { p0[r] = __builtin_amdgcn_exp2f(p0[r]); p1[r] = __builtin_amdgcn_exp2f(p1[r]); } \
    bf16x8 pa0, pa1, pa2, pa3; \
    PK4(p0, 0, pa0); PK4(p0, 8, pa1); PK4(p1, 0, pa2); PK4(p1, 8, pa3); \
    asm volatile("s_waitcnt lgkmcnt(0)" ::: "memory"); SBAR(); \
    o0 = MFMA32(pa0, PKV(va0, vb0_), o0); o1 = MFMA32(pa0, PKV(wa0, wb0), o1); lacc = MFMA32(pa0, ones, lacc); \
    o0 = MFMA32(pa1, PKV(va1, vb1_), o0); o1 = MFMA32(pa1, PKV(wa1, wb1), o1); lacc = MFMA32(pa1, ones, lacc); \
    o0 = MFMA32(pa2, PKV(va2, vb2_), o0); o1 = MFMA32(pa2, PKV(wa2, wb2), o1); lacc = MFMA32(pa2, ones, lacc); \
    o0 = MFMA32(pa3, PKV(va3, vb3_), o0); o1 = MFMA32(pa3, PKV(wa3, wb3), o1); lacc = MFMA32(pa3, ones, lacc); \
    SBAR(); \
} while (0)
#define PK4(P, BASE, OUT) do { u32x4 w_ = {cvtpk_s(P[BASE + 0], P[BASE + 1]), cvtpk_s(P[BASE + 2], P[BASE + 3]), cvtpk_s(P[BASE + 4], P[BASE + 5]), cvtpk_s(P[BASE + 6], P[BASE + 7])}; \
    OUT = __builtin_bit_cast(bf16x8, w_); } while (0)
__device__ __forceinline__ void attn_tile(const LAS unsigned char* Kc  , int vb, const bf16x8 q0, const bf16x8 q1, f32x16& negm, float& m,
                                          f32x16& o0, f32x16& o1, f32x16& lacc, bool first, LAS float* wsf, int r32, int hi) {
    const LAS unsigned char* kp = Kc + r32 * 144 + hi * 16;
    const bf16x8 ones = {0x3F80, 0x3F80, 0x3F80, 0x3F80, 0x3F80, 0x3F80, 0x3F80, 0x3F80};
    bf16x8 k0 = *(const LAS bf16x8*)(kp), k1 = *(const LAS bf16x8*)(kp + 32), k2 = *(const LAS bf16x8*)(kp + 32 * 144), k3 = *(const LAS bf16x8*)(kp + 32 * 144 + 32);
    AT_SUBTILE(0, first);
    AT_SUBTILE(1, false);
}
#undef PK4
#undef AT_SUBTILE

template <int VAR>
__device__ __forceinline__ void attn_unit(const Args& a, int l, int b, int h, int qrow0  , bool ctxu, const bf16* Z, bf16* Y, LAS unsigned char* lds) {
    const int tid = opaque_tid(), lane = tid & 63, wave = __builtin_amdgcn_readfirstlane(tid >> 6), r32 = lane & 31, hi = lane >> 5;
    const int comp = wave >> 2, wq = wave & 3;
    const int NT = ctxu ? 2 : 66;
    const bf16* kcp = (const bf16*)(a.ws + WS_KC) + (size_t)(b * 4 + h) * 8448 * 64; const bf16* vcp = (const bf16*)(a.ws + WS_VC) + (size_t)(b * 4 + h) * 8448 * 64;
    bf16x8 q0, q1;
    { const bf16* qp = Z + (size_t)(qrow0 + wq * 32 + r32) * DIN + 512 + h * 64 + comp * 32 + hi * 8; q0 = *(const bf16x8*)(qp); q1 = *(const bf16x8*)(qp + 16); }
    const int sr = tid >> 3, sc = (tid & 7) * 8;
    const int kst0 = sr * 144 + sc * 2, kst1 = kst0 + 64 * 144, vst0 = v_st_nat(sr, sc), vst1 = v_st_nat(sr + 64, sc);
    const int vb0 = (int)(unsigned)(uintptr_t)(lds + AT_V) + v_rd_base(lane);
    LAS float* wsf = (LAS float*)(lds + AT_WS) + wave * 64;
    f32x16 negm = f32x16{}, o0 = f32x16{}, o1 = f32x16{}, lacc = f32x16{};
    float m = 0.f;
    bf16x8 ka0, ka1, va0, va1, kb0, kb1, vb0_, vb1_;
#define AT_LOAD(K0, K1, V0, V1, T) do { const size_t e_ = (size_t)(128 * (T) + sr) * 64 + sc; \
        K0 = *(const bf16x8*)(kcp + e_); V0 = *(const bf16x8*)(vcp + e_); K1 = *(const bf16x8*)(kcp + e_ + 64 * 64); V1 = *(const bf16x8*)(vcp + e_ + 64 * 64); } while (0)
#define AT_STORE(K0, K1, V0, V1, BUF) do { *(LAS bf16x8*)(lds + AT_K + (BUF) * AT_KB + kst0) = K0; *(LAS bf16x8*)(lds + AT_K + (BUF) * AT_KB + kst1) = K1; \
        *(LAS bf16x8*)(lds + AT_V + (BUF) * AT_VB + vst0) = V0; *(LAS bf16x8*)(lds + AT_V + (BUF) * AT_VB + vst1) = V1; } while (0)
    AT_LOAD(ka0, ka1, va0, va1, 0); AT_LOAD(kb0, kb1, vb0_, vb1_, 1); AT_STORE(ka0, ka1, va0, va1, 0);
    const LAS unsigned char* Kb0 = lds + AT_K + comp * 64;
    for (int t = 0; t < NT; t += 2) {
        __syncthreads();
        if (t + 2 < NT) AT_LOAD(ka0, ka1, va0, va1, t + 2);
        attn_tile(Kb0, vb0, q0, q1, negm, m, o0, o1, lacc, t == 0, wsf, r32, hi);
        AT_STORE(kb0, kb1, vb0_, vb1_, 1);
        __syncthreads();
        if (t + 3 < NT) AT_LOAD(kb0, kb1, vb0_, vb1_, t + 3);
        attn_tile(Kb0 + AT_KB, vb0 + AT_VB, q0, q1, negm, m, o0, o1, lacc, false, wsf, r32, hi);
        if (t + 2 < NT) AT_STORE(ka0, ka1, va0, va1, 0);
    }
#undef AT_LOAD
#undef AT_STORE
    float lam, omli;
    { float s1 = 0.f, s2 = 0.f;
      for (int i = 0; i < 32; ++i) { s1 += a.lam_q1[l * 32 + i] * a.lam_k1[l * 32 + i]; s2 += a.lam_q2[l * 32 + i] * a.lam_k2[l * 32 + i]; }
      const float li = 0.8f - 0.6f * expf(-0.3f * (float)l); lam = expf(s1) - expf(s2) + li; omli = 1.f - li; }
    LAS float* stg = (LAS float*)(lds + AT_ST) + wq * 2048;
    if (comp == 1) {
#pragma unroll
        for (int r = 0; r < 16; ++r) { const int qr = crow(r, hi); const float il = lam * __builtin_amdgcn_rcpf(lacc[r]); stg[qr * 64 + r32] = o0[r] * il; stg[qr * 64 + 32 + r32] = o1[r] * il; }
    }
    __syncthreads();
    if (comp == 0) {
#pragma unroll
        for (int r = 0; r < 16; ++r) { const int qr = crow(r, hi); const float il = __builtin_amdgcn_rcpf(lacc[r]); o0[r] = o0[r] * il - stg[qr * 64 + r32]; o1[r] = o1[r] * il - stg[qr * 64 + 32 + r32]; }
        asm volatile("s_waitcnt lgkmcnt(0)" ::: "memory");
#pragma unroll
        for (int r = 0; r < 16; ++r) { const int qr = crow(r, hi); stg[qr * 64 + r32] = o0[r]; stg[qr * 64 + 32 + r32] = o1[r]; }
        asm volatile("s_waitcnt lgkmcnt(0)" ::: "memory");
        const int ch = lane & 7;
        float gsub[8];
#pragma unroll
        for (int i = 0; i < 8; ++i) gsub[i] = a.subln_g[l * 64 + ch * 8 + i] * omli;
#pragma unroll
        for (int i = 0; i < 4; ++i) { const int row = i * 8 + (lane >> 3);
            const f32x4 x0 = *(const LAS f32x4*)(stg + row * 64 + ch * 8), x1 = *(const LAS f32x4*)(stg + row * 64 + ch * 8 + 4);
            float ss = (x0.x * x0.x + x0.y * x0.y) + (x0.z * x0.z + x0.w * x0.w) + (x1.x * x1.x + x1.y * x1.y) + (x1.z * x1.z + x1.w * x1.w);
            ss = sum8(ss);
            const float rs = rsqrtf(ss * (1.f / 64.f) + 1e-6f);
            float o[8] = {x0.x * rs * gsub[0], x0.y * rs * gsub[1], x0.z * rs * gsub[2], x0.w * rs * gsub[3], x1.x * rs * gsub[4], x1.y * rs * gsub[5], x1.z * rs * gsub[6], x1.w * rs * gsub[7]};
            *(u32x4*)(Y + (size_t)(qrow0 + wq * 32 + row) * DM + 256 + h * 64 + ch * 8) = pk8(o); }
    }
    __syncthreads();
}

#define XB_TMO      128
#define XB_XCNT(j)  (256  + 64 * (j))
#define XB_XSUB(j)  (1280 + 64 * (j))
#define XB_XGEN(j)  (2304 + 64 * (j))
#define XB_TOP      3328
#define XB_TOPGEN   3392
#define XCD_BAR_WORDS 3456
#define XB_SPIN_CAP (1u << 18)

__device__ __forceinline__ unsigned xb_ld(unsigned* p)              { return __hip_atomic_load(p, __ATOMIC_RELAXED, __HIP_MEMORY_SCOPE_AGENT); }
__device__ __forceinline__ unsigned xb_add(unsigned* p, unsigned v) { return __hip_atomic_fetch_add(p, v, __ATOMIC_RELAXED, __HIP_MEMORY_SCOPE_AGENT); }
__device__ __forceinline__ unsigned xb_xcc_id() { return (unsigned)__builtin_amdgcn_s_getreg((3 << 11) | 20) & 0xFu; }
#define XB_SPIN(cond, bar) do { unsigned _sp = 0; while (cond) { __builtin_amdgcn_s_sleep(1); \
    if ((++_sp & 255u) == 0u) { if (xb_ld(&(bar)[XB_TMO])) break; if (_sp > XB_SPIN_CAP) { atomicAdd(&(bar)[XB_TMO], 1u); break; } } } } while (0)

struct XcdBarrier {
    unsigned* bar; unsigned x;
    volatile LAS unsigned* st;
};

__device__ __forceinline__ XcdBarrier xcd_barrier_post(unsigned* bar, volatile LAS unsigned* st) {
    XcdBarrier b; b.bar = bar; b.x = xb_xcc_id(); b.st = st;
    if (threadIdx.x == 0) (void)xb_add(&bar[XB_XCNT(b.x)], 1u);
    return b;
}
__device__ __forceinline__ void xcd_barrier_complete(unsigned* bar, unsigned x, unsigned& nloc, unsigned& nx) {
    const unsigned G = gridDim.x * gridDim.y * gridDim.z;
    unsigned sum, cnt, mine, sp = 0u;
    for (;;) {
        sum = 0u; cnt = 0u; mine = 0u;
#pragma unroll
        for (unsigned j = 0; j < 16; ++j) { const unsigned c = xb_ld(&bar[XB_XCNT(j)]); sum += c; cnt += (c > 0u) ? 1u : 0u; mine = (j == x) ? c : mine; }
        if (sum == G) break;
        __builtin_amdgcn_s_sleep(1);
        if ((++sp & 255u) == 0u) { if (xb_ld(&bar[XB_TMO])) break; if (sp > XB_SPIN_CAP) { atomicAdd(&bar[XB_TMO], 1u); break; } }
    }
    nloc = mine > 0u ? mine : 1u; nx = cnt > 0u ? cnt : 1u;
}

__device__ __forceinline__ void xcd_barrier(const XcdBarrier& b) {
    asm volatile("s_waitcnt vmcnt(0)" ::: "memory");
    __syncthreads();
    if (threadIdx.x == 0) {
        unsigned* bar = b.bar;
        __builtin_amdgcn_s_waitcnt(0);
        unsigned nloc = b.st[0], nx = b.st[1];
        if (nloc == 0u) { xcd_barrier_complete(bar, b.x, nloc, nx); b.st[0] = nloc; b.st[1] = nx; }
        const unsigned old = xb_add(&bar[XB_XSUB(b.x)], 1u);
        const unsigned gen = old / nloc;
        if (old + 1u == (gen + 1u) * nloc) {
            __builtin_amdgcn_fence(__ATOMIC_RELEASE, "agent");
            asm volatile("s_waitcnt vmcnt(0)" ::: "memory");
            const unsigned og = xb_add(&bar[XB_TOP], 1u);
            const unsigned tg = og / nx;
            if (og + 1u == (tg + 1u) * nx) xb_add(&bar[XB_TOPGEN], 1u);
            else XB_SPIN(xb_ld(&bar[XB_TOPGEN]) == tg, bar);
            __builtin_amdgcn_fence(__ATOMIC_ACQUIRE, "agent");
            xb_add(&bar[XB_XGEN(b.x)], 1u);
            asm volatile("s_waitcnt vmcnt(0)" ::: "memory");
        } else {
            XB_SPIN(xb_ld(&bar[XB_XGEN(b.x)]) == gen, bar);
            __builtin_amdgcn_fence(__ATOMIC_ACQUIRE, "agent");
            asm volatile("s_waitcnt vmcnt(0)" ::: "memory");
        }
    }
    __syncthreads();
}

__global__ void __launch_bounds__(512, 2) fwd_megakernel(Args a) {
    extern __shared__ __attribute__((aligned(16))) unsigned char lds_raw[];
    LAS unsigned char* lds = (LAS unsigned char*)lds_raw;
    const int G = gridDim.x, blk = blockIdx.x;
    unsigned char* ws = a.ws;
    bf16* XN = (bf16*)(ws + WS_XN); bf16* Zb = (bf16*)(ws + WS_Z); bf16* Yb = (bf16*)(ws + WS_Y); bf16* Hb = (bf16*)(ws + WS_H);
    float* XC = (float*)(ws + WS_XC); bf16* XB = (bf16*)(ws + WS_XB); const float* mod = (const float*)(ws + WS_MOD);
    const float* rc = (const float*)(ws + WS_ROPE); const float* rs = rc + 1024;
    const int lo = a.ph_lo, hi_ = a.ph_hi;
    volatile LAS unsigned* MISC = (volatile LAS unsigned*)(lds + 131072 + 64);
    if (threadIdx.x < 4) MISC[threadIdx.x] = 0u;
    __syncthreads();
    XcdBarrier bar; bar.bar = (unsigned*)ws + 1024; bar.x = 0; bar.st = nullptr;
    if (hi_ - lo > 1) bar = xcd_barrier_post((unsigned*)ws + 1024, MISC);
#define IN(k) (lo <= (k) && (k) < hi_)
#define SEAM(k) do { if (IN(k) && IN((k) + 1)) { if (lo < 0) { __threadfence(); cg::this_grid().sync(); } else xcd_barrier(bar); } } while (0)
    #ifndef SKIP_PRO
    if (IN(0)) { for (int rep_ = 0; rep_ < PROBE_LIGHT; ++rep_) phase_prologue(a, lds, G); }
#endif
    SEAM(0);
    for (int l = 0; l < 2; ++l) {
        const int P = 1 + 7 * l;
        const float* modl = mod + (size_t)l * 5 * 6144;
        const int rows_all = NROWS, rows_mix = (l == 0) ? NROWS : NLAT;
        if (IN(P)) for (int rep_ = 0; rep_ < PROBE_LIGHT; ++rep_) phase_modnorm(l == 0 ? a.x : nullptr, XB, l == 0 ? a.ctx : XC, XN, a.norm1_g + l * DM, modl, modl + 1024, rows_all, G);
        SEAM(P);
#ifndef SKIP_G1
        if (IN(P + 1)) { pg8::Gemm g{XN, (const bf16*)(ws + WS_WIN) + (size_t)l * DIN * DM, rows_all, DIN, DM, DM}; pg8::StaticOrder S; S.init(rows_all, DIN, G, blk);
            pg8::EpiZ E{Zb, rc, rs, (bf16*)(ws + WS_KC), (bf16*)(ws + WS_VC)}; pg8::gemm_phase<pg8::EpiZ, pg8::StaticOrder, true, true>(lds, g, S, E); }
#endif
        SEAM(P + 1);
        if (IN(P + 2)) {
            const int n_conv = rows_mix / 64, n_sg = rows_mix / 128, n_at = 512 + (l == 0 ? 16 : 0);
#ifndef SKIP_SG
            for (int rep_ = 0; rep_ < PROBE_LIGHT; ++rep_) for (int u = (blk + 3 * G / 4) % G; u < n_sg; u += G) sg_unit(a, l, u, Zb, Yb, lds);
#endif
#ifndef SKIP_CONV
            for (int rep_ = 0; rep_ < PROBE_LIGHT; ++rep_) for (int u = (blk + G / 2) % G; u < n_conv; u += G) conv_unit(a, l, u, Zb, Yb, lds);
#endif
#ifndef SKIP_ATTN
            for (int rep_ = 0; rep_ < PROBE_ATT; ++rep_) {
            {
                const int xcd = blk & 7, cu = blk >> 3, per = G >> 3;
                const bool xm = (G & 7) == 0;
                for (int i = 0;; ++i) { const int j = xm ? cu + i * per : blk + i * G; if (j >= (xm ? 128 : 1024)) break;
                    const int bh = xm ? xcd * 2 + (j >> 6) : (j >> 6), qb = j & 63; if (rep_ == 0) attn_unit<0>(a, l, bh >> 2, bh & 3, (bh >> 2) * SEQ + qb * 128, false, Zb, Yb, lds); else attn_unit<PROBE_VAR>(a, l, bh >> 2, bh & 3, (bh >> 2) * SEQ + qb * 128, false, Zb, (bf16*)(ws + 384 * MiB), lds); }
            }
            if (l == 0 && rep_ == 0) for (int u = (blk + G / 4) % G; u < 32; u += G) { const int bh = u >> 1; attn_unit<0>(a, l, bh >> 2, bh & 3, NLAT + (bh >> 2) * NCTX + (u & 1) * 128, true, Zb, Yb, lds); }
            }
#endif
        }
        SEAM(P + 2);
#ifndef SKIP_G2
        if (IN(P + 3)) { pg8::Gemm g{Yb, (const bf16*)(ws + WS_WOUT) + (size_t)l * DM * DM, rows_mix, DM, DM, DM}; pg8::StaticOrder S; S.init(rows_mix, DM, G, blk);
            pg8::EpiRes E{l == 0 ? a.x : nullptr, XB, l == 0 ? a.ctx : XC, XB, XC, modl + 2 * 1024}; pg8::gemm_phase<pg8::EpiRes, pg8::StaticOrder, true, true>(lds, g, S, E); }
#endif
        SEAM(P + 3);
        if (IN(P + 4)) for (int rep_ = 0; rep_ < PROBE_LIGHT; ++rep_) phase_modnorm(nullptr, XB, XC, XN, a.norm2_g + l * DM, modl + 3 * 1024, modl + 4 * 1024, rows_mix, G);
        SEAM(P + 4);
#ifndef SKIP_G3
        if (IN(P + 5)) { pg8::Gemm g{XN, (const bf16*)(ws + WS_W1) + (size_t)l * DFF * DM, rows_mix, DFF, DM, DM}; pg8::StaticOrder S; S.init(rows_mix, DFF, G, blk);
            pg8::EpiRelu2 E{Hb}; pg8::gemm_phase<pg8::EpiRelu2, pg8::StaticOrder, true, true>(lds, g, S, E); }
#endif
        SEAM(P + 5);
#ifndef SKIP_G2
        if (IN(P + 6)) { pg8::Gemm g{Hb, (const bf16*)(ws + WS_W2) + (size_t)l * DM * DFF, NLAT, DM, DFF, DFF}; pg8::StaticOrder S; S.init(NLAT, DM, G, blk);
            pg8::EpiRes E{nullptr, XB, XC, XB, XC, modl + 5 * 1024}; pg8::gemm_phase<pg8::EpiRes, pg8::StaticOrder, true, true>(lds, g, S, E);
            if (l == 0) {
                pg8::Gemm gc{Hb, (const bf16*)(ws + WS_W2), NROWS, DM, 1024, DFF}; pg8::CtxSplitOrder Sc{G, blk};
                pg8::EpiResAtomicCtx Ec{XC, modl + 5 * 1024}; pg8::gemm_phase<pg8::EpiResAtomicCtx, pg8::CtxSplitOrder, true, true>(lds, gc, Sc, Ec); } }
#endif
        SEAM(P + 6);
    }
    if (IN(15)) phase_finalnorm(XB, a.out, a.final_g, G);
#undef IN
#undef SEAM
}

#ifndef PROBE_ATT
#define PROBE_ATT 1
#endif
#ifndef MK_SINGLE
#define MK_SINGLE 1
#endif
extern "C" void kernel_launch(void* const* d_in, const int* in_sizes, int n_in, void* d_out, int out_size, void* d_ws, size_t ws_size, hipStream_t stream) {
    static int grid = 0;
    if (grid == 0) {
        if (n_in != 27 || in_sizes[0] != NLAT * DM || out_size != NLAT * DM || ws_size < WS_VC + (size_t)16 * 8448 * 64 * 2) { fprintf(stderr, "kernel_launch: unexpected shapes (n_in %d, in0 %d, out %d, ws %zu < %zu)\n", n_in, n_in > 0 ? in_sizes[0] : -1, out_size, ws_size, (size_t)WS_END); grid = -1; return; }
        if (hipFuncSetAttribute((const void*)fwd_megakernel, hipFuncAttributeMaxDynamicSharedMemorySize, LDS_BYTES) != hipSuccess) { fprintf(stderr, "kernel_launch: hipFuncSetAttribute failed\n"); grid = -1; return; }
        int dev = 0, cus = 0, per_cu = 0;
        hipGetDevice(&dev); hipDeviceGetAttribute(&cus, hipDeviceAttributeMultiprocessorCount, dev);
        hipOccupancyMaxActiveBlocksPerMultiprocessor(&per_cu, (const void*)fwd_megakernel, 512, LDS_BYTES);
        if (per_cu < 1) { fprintf(stderr, "kernel_launch: occupancy query says %d blocks per CU\n", per_cu); per_cu = 1; }
        (void)hipGetLastError();
        grid = cus;
    }
    if (grid < 0) return;
    Args a{};
    const float** f = (const float**)&a;
    for (int i = 0; i < 27; ++i) f[i] = (const float*)d_in[i];
    a.out = (float*)d_out; a.ws = (unsigned char*)d_ws;
#if MK_SINGLE
    if (hipMemsetAsync(d_ws, 0, 32768, stream) != hipSuccess) { fprintf(stderr, "kernel_launch: memset failed\n"); return; }
    a.ph_lo = 0; a.ph_hi = NPHASE;
    void* args[] = {&a};
    hipError_t e = hipLaunchCooperativeKernel((const void*)fwd_megakernel, dim3(grid), dim3(512), args, LDS_BYTES, stream);
    if (e != hipSuccess) fprintf(stderr, "kernel_launch: cooperative launch failed: %s (grid %d)\n", hipGetErrorString(e), grid);
#else
    for (int p = 0; p < NPHASE; ++p) { a.ph_lo = p; a.ph_hi = p + 1; hipLaunchKernelGGL(fwd_megakernel, dim3(grid), dim3(512), LDS_BYTES, stream, a); }
#endif
}
```

```cpp
#include <hip/hip_runtime.h>
#include <hip/hip_cooperative_groups.h>
#include <cstdio>
#include <cstdint>
namespace cg = cooperative_groups;
namespace pg8 {
#define PG8_LAS __attribute__((address_space(3)))
typedef unsigned short bf16_t;
typedef short bf16x8 __attribute__((ext_vector_type(8)));
typedef float f32x4 __attribute__((ext_vector_type(4)));
typedef unsigned u32x4 __attribute__((ext_vector_type(4)));
constexpr int BM = 256, BK = 64, HALF = 128, HTB = HALF * BK * 2  , STAGE_BYTES = 8 * HTB, NXCD = 8, WGM = 8;

__host__ __device__ __forceinline__ int lds_byte(int r, int c) { const int st = (r >> 4) * 2 + (c >> 5), rr = r & 15, cc = c & 31, ob = rr * 64 + cc * 2; return st * 1024 + (ob ^ (((ob >> 9) & 1) << 5)); }
__host__ __device__ __forceinline__ void stage_rc(int b, int& R, int& C) { const int st = b / 1024, sb = b % 1024, swz = sb ^ (((sb >> 9) & 1) << 5); R = (st >> 1) * 16 + swz / 64; C = (st & 1) * 32 + (swz % 64) / 2; }
__host__ __device__ __forceinline__ int perm32(int rho) { const int n = rho >> 4, i = rho & 15; return 8 * (i >> 2) + 4 * n + (i & 3); }

struct Unit { int pm, pn, kb; };
struct Gemm { const bf16_t* A; const bf16_t* Bt; int M, N, K, ld; };

struct StaticOrder {
    int nM, nN, nwg, G, c;
    __host__ __device__ void init(int M, int N, int G_, int c_) { nM = M / BM; nN = N / BM; nwg = nM * nN; G = G_; c = c_; }
    __host__ __device__ bool next(int i, Unit& u) const {
        const long L = (long)i * G + c; if (L >= nwg) return false;
        int wgid = (int)L; { const int q = nwg / NXCD, r = nwg % NXCD, xcd = wgid % NXCD, off = wgid / NXCD; wgid = (xcd < r ? xcd * (q + 1) : r * (q + 1) + (xcd - r) * q) + off; }
        const int nig = WGM * nN, gid = wgid / nig, fm = gid * WGM, gsz = (nM - fm) < WGM ? (nM - fm) : WGM;
        u.pm = fm + ((wgid % nig) % gsz); u.pn = (wgid % nig) / gsz; u.kb = 0; return true;
    }
    __device__ __forceinline__ void a_ready(const Unit&) const {}
    __device__ __forceinline__ void done(const Unit&) const {}
};


__device__ __forceinline__ unsigned cvt_pk_bf16(float lo, float hi) { unsigned r; asm volatile("v_cvt_pk_bf16_f32 %0, %1, %2" : "=v"(r) : "v"(lo), "v"(hi)); return r; }
constexpr int NLAT = 32768;
constexpr float QSCALE = 0.17677669529663687f * 1.4426950408889634f;

struct EpiZ {
    static constexpr bool PERM = true, AFTER_DRAIN = false;
    bf16_t* Z; const float* rc; const float* rs;
    bf16_t* KC; bf16_t* VC;
    __device__ __forceinline__ void operator()(const f32x4 (&acc)[2][2][4][2], const Unit& u, int wr, int wc, int fr, int fq) const {
        const int row0 = u.pm * BM + wr * 64 + fr, col0 = u.pn * BM + wc * 32 + 8 * fq;
        const bool isq = (u.pn == 2), isk = (u.pn == 3), dorope = (u.pm < NLAT / BM) && (isq || isk);
        const float qs = isq ? QSCALE : 1.f;
#pragma unroll
        for (int ai = 0; ai < 2; ++ai)
#pragma unroll
            for (int m = 0; m < 4; ++m) {
                const int row = row0 + ai * HALF + m * 16;
                f32x4 c0 = {1.f, 1.f, 1.f, 1.f}, c1 = c0, s0 = {0.f, 0.f, 0.f, 0.f}, s1 = s0;
                if (dorope) { const int t = row & 8191, pos = (fq >> 1) ? (t & 63) : (t >> 6);
                    c0 = *(const f32x4*)(rc + pos * 8); c1 = *(const f32x4*)(rc + pos * 8 + 4); s0 = *(const f32x4*)(rs + pos * 8); s1 = *(const f32x4*)(rs + pos * 8 + 4);
                    if (!(fq & 1)) { s0 = -s0; s1 = -s1; } }
                bf16_t* rowp = Z + (size_t)row * 2560 + col0; size_t bjstep = HALF;
                if (u.pn == 3 || u.pn == 4) { const bool lt = row < NLAT; const int bb_ = lt ? (row >> 13) : ((row - NLAT) >> 8), key = lt ? 256 + (row & 8191) : ((row - NLAT) & 255);
                    const int cw = wc * 32 + 8 * fq;
                    rowp = (u.pn == 3 ? KC : VC) + ((size_t)(bb_ * 4 + (cw >> 6)) * 8448 + key) * 64 + (cw & 63); bjstep = (size_t)2 * 8448 * 64; }
#pragma unroll
                for (int bj = 0; bj < 2; ++bj) {
                    f32x4 v0 = acc[ai][bj][m][0], v1 = acc[ai][bj][m][1];
                    if (dorope) {
                        f32x4 p0, p1;
#pragma unroll
                        for (int i = 0; i < 4; ++i) {
                            auto ra = __builtin_amdgcn_permlane16_swap(__float_as_uint(v0[i]), __float_as_uint(v0[i]), false, false);
                            auto rb = __builtin_amdgcn_permlane16_swap(__float_as_uint(v1[i]), __float_as_uint(v1[i]), false, false);
                            p0[i] = __uint_as_float((fq & 1) ? ra[0] : ra[1]); p1[i] = __uint_as_float((fq & 1) ? rb[0] : rb[1]); }
                        v0 = v0 * c0 + p0 * s0; v1 = v1 * c1 + p1 * s1;
                    }
                    v0 = v0 * qs; v1 = v1 * qs;
                    u32x4 w; w.x = cvt_pk_bf16(v0[0], v0[1]); w.y = cvt_pk_bf16(v0[2], v0[3]); w.z = cvt_pk_bf16(v1[0], v1[1]); w.w = cvt_pk_bf16(v1[2], v1[3]);
                    *(u32x4*)(rowp + bj * bjstep) = w;
                }
            }
    }
};
struct EpiRelu2 {
    static constexpr bool PERM = true, AFTER_DRAIN = false;
    bf16_t* H;
    __device__ __forceinline__ void operator()(const f32x4 (&acc)[2][2][4][2], const Unit& u, int wr, int wc, int fr, int fq) const {
        const int row0 = u.pm * BM + wr * 64 + fr, col0 = u.pn * BM + wc * 32 + 8 * fq;
#pragma unroll
        for (int ai = 0; ai < 2; ++ai)
#pragma unroll
            for (int m = 0; m < 4; ++m) {
                bf16_t* rowp = H + (size_t)(row0 + ai * HALF + m * 16) * 4096 + col0;
#pragma unroll
                for (int bj = 0; bj < 2; ++bj) {
                    f32x4 v0 = acc[ai][bj][m][0], v1 = acc[ai][bj][m][1];
#pragma unroll
                    for (int i = 0; i < 4; ++i) { const float a = fmaxf(v0[i], 0.f), b = fmaxf(v1[i], 0.f); v0[i] = a * a; v1[i] = b * b; }
                    u32x4 w; w.x = cvt_pk_bf16(v0[0], v0[1]); w.y = cvt_pk_bf16(v0[2], v0[3]); w.z = cvt_pk_bf16(v1[0], v1[1]); w.w = cvt_pk_bf16(v1[2], v1[3]);
                    *(u32x4*)(rowp + bj * HALF) = w;
                }
            }
    }
};
struct EpiRes {
    static constexpr bool PERM = true, AFTER_DRAIN = false;
    const float* baseLf; const bf16_t* baseLb; const float* baseC; bf16_t* outL; float* outC; const float* gate;
    __device__ __forceinline__ void operator()(const f32x4 (&acc)[2][2][4][2], const Unit& u, int wr, int wc, int fr, int fq) const {
        const bool lat = u.pm < NLAT / BM; const int bb = lat ? (u.pm >> 5) : 4;
        const int row0 = (lat ? u.pm * BM : u.pm * BM - NLAT) + wr * 64 + fr, col0 = u.pn * BM + wc * 32 + 8 * fq;
        f32x4 g[2][2];
#pragma unroll
        for (int bj = 0; bj < 2; ++bj)
#pragma unroll
            for (int n = 0; n < 2; ++n) g[bj][n] = *(const f32x4*)(gate + bb * 6144 + col0 + bj * HALF + n * 4);
#pragma unroll
        for (int ai = 0; ai < 2; ++ai)
#pragma unroll
            for (int m = 0; m < 4; ++m) {
                const size_t off = (size_t)(row0 + ai * HALF + m * 16) * 1024 + col0;
#pragma unroll
                for (int bj = 0; bj < 2; ++bj) {
                    f32x4 b0, b1;
                    if (!lat) { b0 = *(const f32x4*)(baseC + off + bj * HALF); b1 = *(const f32x4*)(baseC + off + bj * HALF + 4); }
                    else if (baseLf) { b0 = *(const f32x4*)(baseLf + off + bj * HALF); b1 = *(const f32x4*)(baseLf + off + bj * HALF + 4); }
                    else { const u32x4 w = *(const u32x4*)(baseLb + off + bj * HALF);
                        b0 = (f32x4){__builtin_bit_cast(float, w.x << 16), __builtin_bit_cast(float, w.x & 0xffff0000u), __builtin_bit_cast(float, w.y << 16), __builtin_bit_cast(float, w.y & 0xffff0000u)};
                        b1 = (f32x4){__builtin_bit_cast(float, w.z << 16), __builtin_bit_cast(float, w.z & 0xffff0000u), __builtin_bit_cast(float, w.w << 16), __builtin_bit_cast(float, w.w & 0xffff0000u)}; }
                    const f32x4 o0 = b0 + g[bj][0] * acc[ai][bj][m][0], o1 = b1 + g[bj][1] * acc[ai][bj][m][1];
                    if (!lat) { *(f32x4*)(outC + off + bj * HALF) = o0; *(f32x4*)(outC + off + bj * HALF + 4) = o1; }
                    else { u32x4 w; w.x = cvt_pk_bf16(o0.x, o0.y); w.y = cvt_pk_bf16(o0.z, o0.w); w.z = cvt_pk_bf16(o1.x, o1.y); w.w = cvt_pk_bf16(o1.z, o1.w); *(u32x4*)(outL + off + bj * HALF) = w; }
                }
            }
    }
};

struct CtxSplitOrder {
    int G, c;
    __device__ bool next(int i, Unit& u) const { const int L = i * G + c; if (L >= 64) return false; u.pm = NLAT / BM + (L & 3); u.pn = (L >> 2) & 3; u.kb = (L >> 4) * 1024 * 2; return true; }
    __device__ __forceinline__ void a_ready(const Unit&) const {}
    __device__ __forceinline__ void done(const Unit&) const {}
};
struct EpiResAtomicCtx {
    static constexpr bool PERM = false, AFTER_DRAIN = false;
    float* outC; const float* gate;
    __device__ __forceinline__ void operator()(const f32x4 (&acc)[2][2][4][2], const Unit& u, int wr, int wc, int fr, int fq) const {
        const int row0 = u.pm * BM - NLAT + wr * 64 + fr, col0 = u.pn * BM + wc * 32 + 4 * fq;
#pragma unroll
        for (int bj = 0; bj < 2; ++bj)
#pragma unroll
            for (int n = 0; n < 2; ++n) { const f32x4 g = *(const f32x4*)(gate + 4 * 6144 + col0 + bj * HALF + n * 16);
#pragma unroll
                for (int ai = 0; ai < 2; ++ai)
#pragma unroll
                    for (int m = 0; m < 4; ++m) { float* p = outC + (size_t)(row0 + ai * HALF + m * 16) * 1024 + col0 + bj * HALF + n * 16; const f32x4 v = g * acc[ai][bj][m][n];
#pragma unroll
                        for (int i = 0; i < 4; ++i) __hip_atomic_fetch_add(p + i, v[i], __ATOMIC_RELAXED, __HIP_MEMORY_SCOPE_AGENT); } }
    }
};
template <class Epi, class Sched, bool ALIGN_EPI = false, bool SP2 = false>
__device__ __forceinline__ void gemm_phase(PG8_LAS unsigned char* lds, const Gemm g, const Sched& S, const Epi& E) {
    int tid_ = threadIdx.x; asm volatile("" : "+v"(tid_)); const int tid = tid_, wid = __builtin_amdgcn_readfirstlane(tid >> 6), lane = tid & 63, wr = wid >> 2, wc = wid & 3, fr = lane & 15, fq = lane >> 4;
    const int K = g.K, nt = K / BK;
    unsigned voffA[2], voffB[2];
#pragma unroll
    for (int i = 0; i < 2; ++i) { int R, C; stage_rc(tid * 16 + i * 8192, R, C); const int Rb = Epi::PERM ? ((R & ~31) + perm32(R & 31)) : R;
        voffA[i] = (unsigned)(R * g.ld + C) * 2u; voffB[i] = (unsigned)(Rb * g.ld + C) * 2u; }
    const size_t kstep = (size_t)(BK * 2);
    const size_t hstep = (size_t)HALF * g.ld * 2;
    const size_t tstep = 2 * hstep;
    const unsigned ldsw = (unsigned)wid * 1024u;
    const int aoff = lds_byte(wr * 64 + fr, fq * 8), boff = lds_byte(wc * 32 + fr, fq * 8);
#define PG8_SA(b, h) (((b) * 2 + (h)) * HTB)
#define PG8_SB(b, h) ((4 + (b) * 2 + (h)) * HTB)
#define PG8_STAGE(bufoff, gbase, voff) do { _Pragma("unroll") for (int _i = 0; _i < 2; ++_i) \
        __builtin_amdgcn_global_load_lds((const unsigned*)((const char*)(gbase) + (voff)[_i]), (PG8_LAS unsigned*)(lds + (bufoff) + ldsw + _i * 8192), 16, 0, 0); } while (0)
#define PG8_LDA(dst, b, h) do { _Pragma("unroll") for (int m = 0; m < 4; ++m) _Pragma("unroll") for (int k = 0; k < 2; ++k) dst[m][k] = *(const PG8_LAS bf16x8*)(lds + PG8_SA(b, h) + aoff + m * 2048 + k * 1024); } while (0)
#define PG8_LDB(dst, b, h) do { _Pragma("unroll") for (int n = 0; n < 2; ++n) _Pragma("unroll") for (int k = 0; k < 2; ++k) dst[n][k] = *(const PG8_LAS bf16x8*)(lds + PG8_SB(b, h) + boff + n * 2048 + k * 1024); } while (0)
#define PG8_MMA(ai, bj, At, Bt) do { __builtin_amdgcn_s_setprio(1); _Pragma("unroll") for (int m = 0; m < 4; ++m) _Pragma("unroll") for (int n = 0; n < 2; ++n) _Pragma("unroll") for (int k = 0; k < 2; ++k) \
        acc[ai][bj][m][n] = __builtin_amdgcn_mfma_f32_16x16x32_bf16(Bt[n][k], At[m][k], acc[ai][bj][m][n], 0, 0, 0); __builtin_amdgcn_s_setprio(0); } while (0)
#define PG8_WAIT_V(n) asm volatile("s_waitcnt vmcnt(" #n ")" ::: "memory")
#define PG8_WAIT_L(n) asm volatile("s_waitcnt lgkmcnt(" #n ")" ::: "memory")
#define PG8_BAR __builtin_amdgcn_s_barrier()
#define PG8_SCHED __builtin_amdgcn_sched_barrier(0)
    Unit cur, nxt; int ui = 0;
    if (!S.next(0, cur)) return;
    f32x4 acc[2][2][4][2];
#pragma unroll
    for (int a = 0; a < 2; ++a)
#pragma unroll
        for (int b = 0; b < 2; ++b)
#pragma unroll
            for (int m = 0; m < 4; ++m)
#pragma unroll
                for (int n = 0; n < 2; ++n) acc[a][b][m][n] = (f32x4){0.f, 0.f, 0.f, 0.f};
    bf16x8 At[4][2], B0[2][2], B1[2][2];
    const char* cA = (const char*)g.A + (size_t)cur.pm * tstep + cur.kb; const char* cB = (const char*)g.Bt + (size_t)cur.pn * tstep + cur.kb;
    S.a_ready(cur);
    if constexpr (SP2) {
        PG8_STAGE(PG8_SB(0, 0), cB, voffB); PG8_STAGE(PG8_SB(0, 1), cB + hstep, voffB); PG8_STAGE(PG8_SA(0, 0), cA, voffA); PG8_STAGE(PG8_SA(0, 1), cA + hstep, voffA);
        if (wr == 1) PG8_BAR;
        PG8_WAIT_V(2); PG8_BAR;
        PG8_STAGE(PG8_SB(1, 0), cB + kstep, voffB); PG8_STAGE(PG8_SA(1, 0), cA + kstep, voffA); PG8_STAGE(PG8_SB(1, 1), cB + hstep + kstep, voffB);
        PG8_WAIT_V(6); PG8_BAR;
    } else {
        PG8_STAGE(PG8_SB(0, 0), cB, voffB); PG8_STAGE(PG8_SA(0, 0), cA, voffA); PG8_STAGE(PG8_SB(0, 1), cB + hstep, voffB); PG8_STAGE(PG8_SA(0, 1), cA + hstep, voffA);
        if (wr == 1) PG8_BAR;
        PG8_WAIT_V(4); PG8_BAR;
        PG8_STAGE(PG8_SB(1, 0), cB + kstep, voffB); PG8_STAGE(PG8_SA(1, 0), cA + kstep, voffA); PG8_STAGE(PG8_SB(1, 1), cB + hstep + kstep, voffB);
        PG8_WAIT_V(6); PG8_BAR;
    }
    for (;;) {
        const bool has_next = S.next(ui + 1, nxt);
        const char* nA = has_next ? (const char*)g.A + (size_t)nxt.pm * tstep + nxt.kb : cA; const char* nB = has_next ? (const char*)g.Bt + (size_t)nxt.pn * tstep + nxt.kb : cB;
        for (int t = 0; t < nt; t += 2) {
            const bool last = (t == nt - 2);
            const char* a1 = cA + (size_t)(t + 1) * kstep;
            const char* a2 = last ? nA : cA + (size_t)(t + 2) * kstep; const char* b2 = last ? nB : cB + (size_t)(t + 2) * kstep;
            const char* a3 = a2 + kstep; const char* b3 = b2 + kstep;
            if (last && has_next) S.a_ready(nxt);
            if constexpr (SP2) {
            PG8_LDB(B0, 0, 0); PG8_LDB(B1, 0, 1); PG8_SCHED; PG8_LDA(At, 0, 0); PG8_STAGE(PG8_SA(1, 1), a1 + hstep, voffA);
            PG8_WAIT_V(8); PG8_WAIT_L(0); PG8_BAR; PG8_MMA(0, 0, At, B0); PG8_MMA(0, 1, At, B1); PG8_BAR; PG8_SCHED;
            PG8_LDA(At, 0, 1); PG8_STAGE(PG8_SB(0, 0), b2, voffB); PG8_STAGE(PG8_SB(0, 1), b2 + hstep, voffB); PG8_STAGE(PG8_SA(0, 0), a2, voffA);
            PG8_WAIT_V(8); PG8_WAIT_L(0); PG8_BAR; PG8_MMA(1, 0, At, B0); PG8_MMA(1, 1, At, B1); PG8_BAR; PG8_SCHED;
            PG8_LDB(B0, 1, 0); PG8_LDB(B1, 1, 1); PG8_SCHED; PG8_LDA(At, 1, 0); PG8_STAGE(PG8_SA(0, 1), a2 + hstep, voffA);
            PG8_WAIT_V(8); PG8_WAIT_L(0); PG8_BAR; PG8_MMA(0, 0, At, B0); PG8_MMA(0, 1, At, B1); PG8_BAR; PG8_SCHED;
            PG8_LDA(At, 1, 1); PG8_STAGE(PG8_SB(1, 0), b3, voffB); PG8_STAGE(PG8_SB(1, 1), b3 + hstep, voffB); PG8_STAGE(PG8_SA(1, 0), a3, voffA);
            PG8_WAIT_V(8); PG8_WAIT_L(0); PG8_BAR; PG8_MMA(1, 0, At, B0); PG8_MMA(1, 1, At, B1); PG8_BAR; PG8_SCHED;
            } else {
            PG8_LDB(B0, 0, 0); PG8_SCHED; PG8_LDA(At, 0, 0); PG8_STAGE(PG8_SA(1, 1), a1 + hstep, voffA);
            PG8_WAIT_L(8); PG8_BAR; PG8_WAIT_L(0); PG8_MMA(0, 0, At, B0); PG8_BAR; PG8_SCHED;
            PG8_LDB(B1, 0, 1); PG8_STAGE(PG8_SB(0, 0), b2, voffB);
            PG8_BAR; PG8_WAIT_L(0); PG8_MMA(0, 1, At, B1); PG8_BAR;
            PG8_LDA(At, 0, 1); PG8_STAGE(PG8_SA(0, 0), a2, voffA);
            PG8_BAR; PG8_WAIT_L(0); PG8_MMA(1, 0, At, B0); PG8_BAR; PG8_SCHED;
            PG8_STAGE(PG8_SB(0, 1), b2 + hstep, voffB);
            PG8_WAIT_V(6); PG8_BAR; PG8_MMA(1, 1, At, B1); PG8_BAR;
            PG8_LDB(B0, 1, 0); PG8_SCHED; PG8_LDA(At, 1, 0); PG8_STAGE(PG8_SA(0, 1), a2 + hstep, voffA);
            PG8_WAIT_L(8); PG8_BAR; PG8_WAIT_L(0); PG8_MMA(0, 0, At, B0); PG8_BAR; PG8_SCHED;
            PG8_LDB(B1, 1, 1); PG8_STAGE(PG8_SB(1, 0), b3, voffB);
            PG8_BAR; PG8_WAIT_L(0); PG8_MMA(0, 1, At, B1); PG8_BAR;
            PG8_LDA(At, 1, 1); PG8_STAGE(PG8_SA(1, 0), a3, voffA);
            PG8_BAR; PG8_WAIT_L(0); PG8_MMA(1, 0, At, B0); PG8_BAR; PG8_SCHED;
            PG8_STAGE(PG8_SB(1, 1), b3 + hstep, voffB);
            PG8_WAIT_V(6); PG8_BAR; PG8_MMA(1, 1, At, B1); PG8_BAR;
            }
        }
        if constexpr (ALIGN_EPI) { if (wr == 0) PG8_BAR; }
        if constexpr (!Epi::AFTER_DRAIN) { E(acc, cur, wr, wc, fr, fq); S.done(cur); }
        if (!has_next) break;
#pragma unroll
        for (int a = 0; a < 2; ++a)
#pragma unroll
            for (int b = 0; b < 2; ++b)
#pragma unroll
                for (int m = 0; m < 4; ++m)
#pragma unroll
                    for (int n = 0; n < 2; ++n) acc[a][b][m][n] = (f32x4){0.f, 0.f, 0.f, 0.f};
        cur = nxt; cA = nA; cB = nB; ++ui;
        if constexpr (ALIGN_EPI) { if (wr == 1) PG8_BAR; }
    }
    PG8_WAIT_V(0);
    if constexpr (!ALIGN_EPI) { if (wr == 0) PG8_BAR; }
    PG8_BAR;
    if constexpr (Epi::AFTER_DRAIN) { E.fused(acc, cur, wr, wc, fr, fq, lds, wid, lane); S.done(cur); }
#undef PG8_SA
#undef PG8_SB
#undef PG8_STAGE
#undef PG8_LDA
#undef PG8_LDB
#undef PG8_MMA
#undef PG8_WAIT_V
#undef PG8_WAIT_L
#undef PG8_BAR
#undef PG8_SCHED
}
}

#ifndef PROBE_ATT
#define PROBE_ATT 1
#endif
#ifndef PROBE_VAR
#define PROBE_VAR 0
#endif
#ifndef PROBE_LIGHT
#define PROBE_LIGHT 1
#endif
#define LAS __attribute__((address_space(3)))
__device__ __forceinline__ int opaque_tid() { int t = threadIdx.x; asm volatile("" : "+v"(t)); return t; }
typedef unsigned short bf16;
typedef float f32x4 __attribute__((ext_vector_type(4)));
typedef float f32x16 __attribute__((ext_vector_type(16)));
typedef short bf16x8 __attribute__((ext_vector_type(8)));
typedef short s16x4 __attribute__((ext_vector_type(4)));
typedef unsigned u32x4 __attribute__((ext_vector_type(4)));
typedef unsigned u32x2 __attribute__((ext_vector_type(2)));

constexpr int DM = 1024, NB = 4, SEQ = 8192, NCTX = 256, NLAT = NB * SEQ, NROWS = NLAT + NB * NCTX;
constexpr int DIN = 2560, DFF = 4096;
constexpr size_t MiB = 1u << 20;
constexpr size_t WS_WIN = 1 * MiB, WS_WOUT = 11 * MiB, WS_W1 = 15 * MiB, WS_W2 = 31 * MiB, WS_SGW = 47 * MiB, WS_MOD = WS_SGW + 512 * 1024, WS_ROPE = WS_MOD + 256 * 1024;
constexpr size_t WS_XC = 48 * MiB, WS_XN = 52 * MiB, WS_H = 118 * MiB, WS_Z = WS_H, WS_Y = WS_H + 165 * MiB, WS_END = WS_H + 264 * MiB;
constexpr size_t WS_KC = 448 * MiB, WS_VC = 466 * MiB;
constexpr size_t WS_XB = 384 * MiB;
constexpr int LDS_BYTES = 131072 + 1024;
constexpr int NPHASE = 16;

struct Args {
    const float *x, *c, *ctx, *c_ctx, *ada_w, *ada_b, *norm1_g, *norm2_g, *w_in, *conv_a_w, *conv_a_b, *ln_a_g, *ln_a_b, *lam_q1, *lam_k1, *lam_q2, *lam_k2,
        *subln_g, *sg_ln_g, *sg_ln_b, *sg_w, *sg_b, *conv_d_w, *w_out, *mlp_w1, *mlp_w2, *final_g;
    float* out; unsigned char* ws; int ph_lo, ph_hi;
};

__device__ __forceinline__ unsigned f2bf(float f) { unsigned u = __builtin_bit_cast(unsigned, f); return (u + 0x7fffu + ((u >> 16) & 1u)) >> 16; }
__device__ __forceinline__ unsigned pk2(float lo, float hi) { return pg8::cvt_pk_bf16(lo, hi); }
__device__ __forceinline__ float bf2f(unsigned short v) { return __builtin_bit_cast(float, (unsigned)v << 16); }
__device__ __forceinline__ float bflo(unsigned w) { return __builtin_bit_cast(float, w << 16); }
__device__ __forceinline__ float bfhi(unsigned w) { return __builtin_bit_cast(float, w & 0xffff0000u); }
template <int CTRL> __device__ __forceinline__ float dppmov(float v) { return __builtin_bit_cast(float, __builtin_amdgcn_update_dpp(0, __builtin_bit_cast(int, v), CTRL, 0xf, 0xf, true)); }
__device__ __forceinline__ float sum8(float v) { v += dppmov<0xB1>(v); v += dppmov<0x4E>(v); v += dppmov<0x141>(v); return v; }
__device__ __forceinline__ float sum16(float v) { v = sum8(v); v += dppmov<0x140>(v); return v; }
__device__ __forceinline__ float sum32(float v) { v = sum16(v); auto r = __builtin_amdgcn_permlane16_swap(__float_as_uint(v), __float_as_uint(v), false, false); return __uint_as_float(r[0]) + __uint_as_float(r[1]); }
__device__ __forceinline__ float wave_sum(float v) { v = sum32(v); auto r = __builtin_amdgcn_permlane32_swap(__float_as_uint(v), __float_as_uint(v), false, false); return __uint_as_float(r[0]) + __uint_as_float(r[1]); }
__device__ __forceinline__ float sigmoidf_(float x) { return __builtin_amdgcn_rcpf(1.f + __builtin_amdgcn_exp2f(-1.4426950408889634f * x)); }
__device__ __forceinline__ float gelu_tanh(float x) { const float y2 = 2.302208198144325f * (x + 0.044715f * x * x * x);
    const float t = 1.f - 2.f * __builtin_amdgcn_rcpf(__builtin_amdgcn_exp2f(y2) + 1.f); return 0.5f * x * (1.f + t); }

__device__ __forceinline__ void p0_transpose_item(const float* W, int K, int N, bf16* WT, LAS float* scr, int item, int lane) {
    const int nblk = N / 32, kb = item / nblk, nb = item % nblk, k0 = 64 * kb, n0 = 32 * nb;
#pragma unroll
    for (int i = 0; i < 32; ++i) { const int kk = 2 * i + (lane >> 5); scr[kk * 33 + (lane & 31)] = W[(size_t)(k0 + kk) * N + n0 + (lane & 31)]; }
    asm volatile("s_waitcnt lgkmcnt(0)" ::: "memory");
    const int c = lane & 7;
#pragma unroll
    for (int j = 0; j < 4; ++j) { const int n = (lane >> 3) + 8 * j; const LAS float* s = scr + (8 * c) * 33 + n;
        u32x4 o; o.x = pk2(s[0 * 33], s[1 * 33]); o.y = pk2(s[2 * 33], s[3 * 33]); o.z = pk2(s[4 * 33], s[5 * 33]); o.w = pk2(s[6 * 33], s[7 * 33]);
        *(u32x4*)(WT + (size_t)(n0 + n) * K + k0 + 8 * c) = o; }
    asm volatile("s_waitcnt lgkmcnt(0)" ::: "memory");
}

__device__ __forceinline__ void phase_prologue(const Args& a, LAS unsigned char* lds, int G) {
    const int tid = opaque_tid(), lane = tid & 63, wave = tid >> 6, blk = blockIdx.x;
    unsigned char* ws = a.ws;
    {
        LAS float* S = (LAS float*)lds;
        LAS float* R = (LAS float*)(lds + 20480);
        float* mod = (float*)(ws + WS_MOD);
        bool have = false;
        for (int u = blk; u < 192; u += G) {
            if (!have) { for (int i = tid; i < 5120; i += 512) { const int bb = i >> 10, k = i & 1023; const float v = bb < 4 ? a.c[bb * 1024 + k] : a.c_ctx[k]; S[i] = v * sigmoidf_(v); } __syncthreads(); have = true; }
            const int l = u / 96, col = (u % 96) * 64 + lane;
            const float* W = a.ada_w + (size_t)l * 1024 * 6144 + col;
            float acc[5] = {0.f, 0.f, 0.f, 0.f, 0.f};
#pragma unroll 32
            for (int k = wave * 128; k < wave * 128 + 128; ++k) { const float w = W[(size_t)k * 6144];
#pragma unroll
                for (int bb = 0; bb < 5; ++bb) acc[bb] += S[bb * 1024 + k] * w; }
#pragma unroll
            for (int bb = 0; bb < 5; ++bb) R[(wave * 5 + bb) * 64 + lane] = acc[bb];
            __syncthreads();
            if (tid < 320) { const int bb = tid >> 6; float s = a.ada_b[l * 6144 + col];
#pragma unroll
                for (int w = 0; w < 8; ++w) s += R[(w * 5 + bb) * 64 + lane];
                mod[(size_t)(l * 5 + bb) * 6144 + col] = s; }
            __syncthreads();
        }
        __syncthreads();
    }
    const int gw = blk * 8 + wave, NGW = G * 8;
    {
        LAS float* scr = (LAS float*)(lds + wave * 16384);
        constexpr int I_IN = (DM / 64) * (DIN / 32), I_OUT = (DM / 64) * (DM / 32), I_1 = (DM / 64) * (DFF / 32), I_2 = (DFF / 64) * (DM / 32), I_L = I_IN + I_OUT + I_1 + I_2;
        for (int it = gw; it < 2 * I_L; it += NGW) {
            const int l = it / I_L; int r = it % I_L;
            if (r < I_IN) { p0_transpose_item(a.w_in + (size_t)l * DM * DIN, DM, DIN, (bf16*)(ws + WS_WIN) + (size_t)l * DIN * DM, scr, r, lane); continue; } r -= I_IN;
            if (r < I_OUT) { p0_transpose_item(a.w_out + (size_t)l * DM * DM, DM, DM, (bf16*)(ws + WS_WOUT) + (size_t)l * DM * DM, scr, r, lane); continue; } r -= I_OUT;
            if (r < I_1) { p0_transpose_item(a.mlp_w1 + (size_t)l * DM * DFF, DM, DFF, (bf16*)(ws + WS_W1) + (size_t)l * DFF * DM, scr, r, lane); continue; } r -= I_1;
            p0_transpose_item(a.mlp_w2 + (size_t)l * DFF * DM, DFF, DM, (bf16*)(ws + WS_W2) + (size_t)l * DM * DFF, scr, r, lane);
        }
    }
    {
        const int gt = blk * 512 + tid, NT = G * 512;
        bf16* sgw = (bf16*)(ws + WS_SGW);
        for (int i = gt; i < 2 * 4 * 128 * 128 / 2; i += NT) ((unsigned*)sgw)[i] = pk2(a.sg_w[2 * i], a.sg_w[2 * i + 1]);
        float* rc = (float*)(ws + WS_ROPE); float* rs = rc + 1024;
        if (gt < 1024) { const int pos = gt >> 3, j = gt & 7; const float inv = powf(10000.f, -(float)j / 8.f); const float ang = (float)pos * inv; rc[gt] = cosf(ang); rs[gt] = sinf(ang); }
    }
}

__device__ __forceinline__ void ldrow16(const float* XLf, const bf16* XLb, const float* XC, int r, int lane, f32x4 (&v)[4]) {
    if (r >= NLAT) { const f32x4* p = (const f32x4*)(XC + (size_t)(r - NLAT) * DM) + lane;
#pragma unroll
        for (int j = 0; j < 4; ++j) v[j] = p[64 * j]; }
    else if (XLf) { const f32x4* p = (const f32x4*)(XLf + (size_t)r * DM) + lane;
#pragma unroll
        for (int j = 0; j < 4; ++j) v[j] = p[64 * j]; }
    else { const u32x2* p = (const u32x2*)(XLb + (size_t)r * DM) + lane;
#pragma unroll
        for (int j = 0; j < 4; ++j) { const u32x2 w = p[64 * j]; v[j] = (f32x4){bflo(w.x), bfhi(w.x), bflo(w.y), bfhi(w.y)}; } }
}
__device__ __forceinline__ void phase_modnorm(const float* XLf, const bf16* XLb, const float* XC, bf16* XN, const float* g, const float* shift, const float* scale, int nrows, int G) {
    const int tid = opaque_tid(), lane = tid & 63, gw = blockIdx.x * 8 + (tid >> 6), NGW = G * 8;
    f32x4 gg[4];
#pragma unroll
    for (int j = 0; j < 4; ++j) gg[j] = *(const f32x4*)(g + 4 * (lane + 64 * j));
    for (int r0 = gw; r0 < nrows; r0 += 2 * NGW) {
        const int r1 = r0 + NGW; const bool two = r1 < nrows; const int r1c = two ? r1 : r0;
        const int bb0 = r0 < NLAT ? (r0 >> 13) : 4, bb1 = r1c < NLAT ? (r1c >> 13) : 4;
        f32x4 v[4], w[4], sc0[4], sh0[4], sc1[4], sh1[4]; float s0 = 0.f, s1 = 0.f;
        ldrow16(XLf, XLb, XC, r0, lane, v); ldrow16(XLf, XLb, XC, r1c, lane, w);
#pragma unroll
        for (int j = 0; j < 4; ++j) { const int c = 4 * (lane + 64 * j);
            sc0[j] = *(const f32x4*)(scale + bb0 * 6144 + c); sh0[j] = *(const f32x4*)(shift + bb0 * 6144 + c); sc1[j] = *(const f32x4*)(scale + bb1 * 6144 + c); sh1[j] = *(const f32x4*)(shift + bb1 * 6144 + c); }
#pragma unroll
        for (int j = 0; j < 4; ++j) { s0 += (v[j].x * v[j].x + v[j].y * v[j].y) + (v[j].z * v[j].z + v[j].w * v[j].w); s1 += (w[j].x * w[j].x + w[j].y * w[j].y) + (w[j].z * w[j].z + w[j].w * w[j].w); }
        const float rs0 = rsqrtf(wave_sum(s0) * (1.f / DM) + 1e-6f), rs1 = rsqrtf(wave_sum(s1) * (1.f / DM) + 1e-6f);
        u32x2* o0 = (u32x2*)(XN + (size_t)r0 * DM) + lane; u32x2* o1 = (u32x2*)(XN + (size_t)r1c * DM) + lane;
#pragma unroll
        for (int j = 0; j < 4; ++j) {
            { const f32x4 y = v[j] * rs0 * gg[j] * (sc0[j] + 1.f) + sh0[j]; u32x2 q; q.x = pk2(y.x, y.y); q.y = pk2(y.z, y.w); o0[64 * j] = q; }
            if (two) { const f32x4 y = w[j] * rs1 * gg[j] * (sc1[j] + 1.f) + sh1[j]; u32x2 q; q.x = pk2(y.x, y.y); q.y = pk2(y.z, y.w); o1[64 * j] = q; }
        }
    }
}
__device__ __forceinline__ void phase_finalnorm(const bf16* XB, float* out, const float* g, int G) {
    const int tid = opaque_tid(), lane = tid & 63, gw = blockIdx.x * 8 + (tid >> 6), NGW = G * 8;
    f32x4 gg[4];
#pragma unroll
    for (int j = 0; j < 4; ++j) gg[j] = *(const f32x4*)(g + 4 * (lane + 64 * j));
    for (int r0 = gw; r0 < NLAT; r0 += 2 * NGW) {
        const int r1 = r0 + NGW; const bool two = r1 < NLAT; const int r1c = two ? r1 : r0;
        f32x4 v[4], w[4]; float s0 = 0.f, s1 = 0.f;
        ldrow16(nullptr, XB, nullptr, r0, lane, v); ldrow16(nullptr, XB, nullptr, r1c, lane, w);
#pragma unroll
        for (int j = 0; j < 4; ++j) { s0 += (v[j].x * v[j].x + v[j].y * v[j].y) + (v[j].z * v[j].z + v[j].w * v[j].w); s1 += (w[j].x * w[j].x + w[j].y * w[j].y) + (w[j].z * w[j].z + w[j].w * w[j].w); }
        const float rs0 = rsqrtf(wave_sum(s0) * (1.f / DM) + 1e-6f), rs1 = rsqrtf(wave_sum(s1) * (1.f / DM) + 1e-6f);
        f32x4* o0 = (f32x4*)(out + (size_t)r0 * DM) + lane; f32x4* o1 = (f32x4*)(out + (size_t)r1c * DM) + lane;
#pragma unroll
        for (int j = 0; j < 4; ++j) { o0[64 * j] = v[j] * rs0 * gg[j]; if (two) o1[64 * j] = w[j] * rs1 * gg[j]; }
    }
}

__device__ __forceinline__ void ld8bf(const bf16* p, float (&o)[8]) {
    const u32x4 w = *(const u32x4*)p;
    o[0] = bflo(w.x); o[1] = bfhi(w.x); o[2] = bflo(w.y); o[3] = bfhi(w.y); o[4] = bflo(w.z); o[5] = bfhi(w.z); o[6] = bflo(w.w); o[7] = bfhi(w.w);
}
__device__ __forceinline__ u32x4 pk8(const float (&v)[8]) { u32x4 w; w.x = pk2(v[0], v[1]); w.y = pk2(v[2], v[3]); w.z = pk2(v[4], v[5]); w.w = pk2(v[6], v[7]); return w; }

__device__ __forceinline__ void conv_unit(const Args& a, int l, int tile, const bf16* Z, bf16* Y, LAS unsigned char* lds) {
    const int tid = opaque_tid(), lane = tid & 63, wave = tid >> 6;
    const int R0 = tile * 64; const bool lat = R0 < NLAT;
    const int seq0 = lat ? (R0 & ~(SEQ - 1)) : NLAT + ((R0 - NLAT) & ~(NCTX - 1)), seq1 = seq0 + (lat ? SEQ : NCTX);
    LAS unsigned short* Gl = (LAS unsigned short*)lds;
    LAS float* Yl = (LAS float*)(lds + 49152);
    {
        u32x4 rv[6], rg[6];
#pragma unroll
        for (int i = 0; i < 6; ++i) { const int it = tid + 512 * i, pr = it >> 5, ch = (it & 31) * 8, row = R0 - 15 + pr;
            rv[i] = (u32x4){0u, 0u, 0u, 0u}; rg[i] = rv[i];
            if (it < 94 * 32 && row >= seq0 && row < seq1) { rv[i] = *(const u32x4*)(Z + (size_t)row * DIN + ch); rg[i] = *(const u32x4*)(Z + (size_t)row * DIN + 256 + ch); } }
#pragma unroll
        for (int i = 0; i < 6; ++i) { const int it = tid + 512 * i, pr = it >> 5, ch = (it & 31) * 8;
            if (it < 94 * 32) {
                const float av[8] = {bflo(rv[i].x), bfhi(rv[i].x), bflo(rv[i].y), bfhi(rv[i].y), bflo(rv[i].z), bfhi(rv[i].z), bflo(rv[i].w), bfhi(rv[i].w)};
                const float ag[8] = {bflo(rg[i].x), bfhi(rg[i].x), bflo(rg[i].y), bfhi(rg[i].y), bflo(rg[i].z), bfhi(rg[i].z), bflo(rg[i].w), bfhi(rg[i].w)};
                float o[8];
#pragma unroll
                for (int j = 0; j < 8; ++j) o[j] = av[j] * sigmoidf_(ag[j]);
                *(LAS u32x4*)(Gl + pr * 256 + ch) = pk8(o); } }
    }
    const f32x4 lng = *(const f32x4*)(a.ln_a_g + l * 256 + 4 * lane), lnb = *(const f32x4*)(a.ln_a_b + l * 256 + 4 * lane);
    float w[31];
#pragma unroll
    for (int k = 0; k < 31; ++k) w[k] = a.conv_a_w[(size_t)l * 31 * 256 + k * 256 + (tid & 255)];
    const float bias = a.conv_a_b[l * 256 + (tid & 255)];
    __syncthreads();
    {
        const int c = tid & 255, ph = tid >> 8;
        float acc[32];
#pragma unroll
        for (int p = 0; p < 32; ++p) acc[p] = bias;
        const LAS unsigned short* gp = Gl + (ph * 32) * 256 + c;
        unsigned short graw[62];
#pragma unroll
        for (int j = 0; j < 62; ++j) graw[j] = gp[j * 256];
#pragma unroll
        for (int j = 0; j < 62; ++j) { const float g = bf2f(graw[j]);
#pragma unroll
            for (int p = 0; p < 32; ++p) { const int k = j - p; if (k >= 0 && k < 31) acc[p] += w[k] * g; } }
#pragma unroll
        for (int p = 0; p < 32; ++p) Yl[(ph * 32 + p) * 256 + c] = acc[p];
    }
    __syncthreads();
    {
        const f32x4 gg = lng, bb = lnb;
#pragma unroll
        for (int i = 0; i < 8; ++i) { const int p = wave * 8 + i;
            const f32x4 v = *(const LAS f32x4*)(Yl + p * 256 + 4 * lane);
            const float mean = wave_sum((v.x + v.y) + (v.z + v.w)) * (1.f / 256.f);
            const f32x4 d = v - mean;
            const float var = wave_sum((d.x * d.x + d.y * d.y) + (d.z * d.z + d.w * d.w)) * (1.f / 256.f);
            f32x4 y = d * rsqrtf(var + 1e-6f) * gg + bb;
            y.x *= sigmoidf_(y.x); y.y *= sigmoidf_(y.y); y.z *= sigmoidf_(y.z); y.w *= sigmoidf_(y.w);
            u32x2 o; o.x = pk2(y.x, y.y); o.y = pk2(y.z, y.w);
            *(u32x2*)(Y + (size_t)(R0 + p) * DM + 4 * lane) = o; }
    }
    {
        const int ch = (tid & 31) * 8;
        const f32x4 wa0 = *(const f32x4*)(a.conv_d_w + l * 768 + ch), wa1 = *(const f32x4*)(a.conv_d_w + l * 768 + ch + 4), wb0 = *(const f32x4*)(a.conv_d_w + l * 768 + 256 + ch), wb1 = *(const f32x4*)(a.conv_d_w + l * 768 + 256 + ch + 4),
                    wc0 = *(const f32x4*)(a.conv_d_w + l * 768 + 512 + ch), wc1 = *(const f32x4*)(a.conv_d_w + l * 768 + 512 + ch + 4);
        const float w0[8] = {wa0.x, wa0.y, wa0.z, wa0.w, wa1.x, wa1.y, wa1.z, wa1.w}, w1[8] = {wb0.x, wb0.y, wb0.z, wb0.w, wb1.x, wb1.y, wb1.z, wb1.w}, w2[8] = {wc0.x, wc0.y, wc0.z, wc0.w, wc1.x, wc1.y, wc1.z, wc1.w};
#pragma unroll
        for (int half = 0; half < 2; ++half) {
            u32x4 rb[2], c0[2], x0[2], cm[2], xm[2], cp[2], xp[2];
#pragma unroll
            for (int i = 0; i < 2; ++i) { const int row = R0 + (tid >> 5) + 16 * (2 * half + i); const bf16* zr = Z + (size_t)row * DIN + ch; const u32x4 z4 = {0u, 0u, 0u, 0u};
                rb[i] = *(const u32x4*)(zr + 1792); c0[i] = *(const u32x4*)(zr + 2048); x0[i] = *(const u32x4*)(zr + 2304);
                cm[i] = z4; xm[i] = z4; cp[i] = z4; xp[i] = z4;
                if (row - 1 >= seq0) { cm[i] = *(const u32x4*)(zr - DIN + 2048); xm[i] = *(const u32x4*)(zr - DIN + 2304); }
                if (row + 1 < seq1) { cp[i] = *(const u32x4*)(zr + DIN + 2048); xp[i] = *(const u32x4*)(zr + DIN + 2304); } }
#pragma unroll
            for (int i = 0; i < 2; ++i) { const int row = R0 + (tid >> 5) + 16 * (2 * half + i);
#define UNPK(V) {bflo(V.x), bfhi(V.x), bflo(V.y), bfhi(V.y), bflo(V.z), bfhi(V.z), bflo(V.w), bfhi(V.w)}
                const float bg[8] = UNPK(rb[i]), a0[8] = UNPK(c0[i]), b0[8] = UNPK(x0[i]), am[8] = UNPK(cm[i]), bm[8] = UNPK(xm[i]), ap[8] = UNPK(cp[i]), bp[8] = UNPK(xp[i]);
#undef UNPK
                float o[8];
#pragma unroll
                for (int j = 0; j < 8; ++j) o[j] = bg[j] * (w0[j] * (am[j] * bm[j]) + w1[j] * (a0[j] * b0[j]) + w2[j] * (ap[j] * bp[j]));
                *(u32x4*)(Y + (size_t)row * DM + 768 + ch) = pk8(o); }
        }
    }
    __syncthreads();
}

__device__ __forceinline__ int v_st(int k, int c) { const int kk = (k & ~0xC) | ((k & 4) << 1) | ((k & 8) >> 1); return ((kk >> 3) * 2 + (c >> 5)) * 512 + ((kk & 7) * 32 + (c & 31)) * 2; }
__device__ __forceinline__ int v_st_nat(int k, int c) { return ((k >> 3) * 2 + (c >> 5)) * 512 + ((k & 7) * 32 + (c & 31)) * 2; }
__device__ __forceinline__ int v_rd_base(int lane) { return ((lane & 3) << 3) | (((lane >> 2) & 3) << 6) | (((lane >> 4) & 1) << 5) | (((lane >> 5) & 1) << 8); }
constexpr int v_rd_off(int d0, int ks, int half) { return d0 * 512 + ks * 2048 + half * 1024; }
template <int OFF> __device__ __forceinline__ s16x4 tr_read(int vb) { s16x4 r; asm volatile("ds_read_b64_tr_b16 %0, %1 offset:%2" : "=&v"(r) : "v"(vb), "i"(OFF) : "memory"); return r; }
__device__ __forceinline__ int crow(int r, int hi) { return (r & 3) + 8 * (r >> 2) + 4 * hi; }
#define SBAR() __builtin_amdgcn_sched_barrier(0)
#define MFMA32(a, b, c) __builtin_amdgcn_mfma_f32_32x32x16_bf16((a), (b), (c), 0, 0, 0)
#define PKV(L, H) (bf16x8){L[0], L[1], L[2], L[3], H[0], H[1], H[2], H[3]}

__device__ __forceinline__ void sg_unit(const Args& a, int l, int chunk, const bf16* Z, bf16* Y, LAS unsigned char* lds) {
    const int tid = opaque_tid(), lane = tid & 63, wave = tid >> 6, r32 = lane & 31, hi = lane >> 5;
    const int R0 = chunk * 128;
    bf16x8 wa[8][2];
    { const bf16* Wg0 = (const bf16*)(a.ws + WS_SGW) + (size_t)(l * 4 + (wave >> 1)) * 128 * 128 + (size_t)(64 * (wave & 1) + r32) * 128 + 8 * hi;
#pragma unroll
      for (int ks = 0; ks < 8; ++ks) { wa[ks][0] = *(const bf16x8*)(Wg0 + 16 * ks); wa[ks][1] = *(const bf16x8*)(Wg0 + 32 * 128 + 16 * ks); } }
    {
        const int hw = tid >> 5;
        float gg[8], bb[8];
#pragma unroll
        for (int i = 0; i < 8; ++i) { gg[i] = a.sg_ln_g[l * 256 + 8 * r32 + i]; bb[i] = a.sg_ln_b[l * 256 + 8 * r32 + i]; }
        u32x4 raw[8];
#pragma unroll
        for (int i = 0; i < 8; ++i) raw[i] = *(const u32x4*)(Z + (size_t)(R0 + hw + 16 * i) * DIN + 1536 + 8 * r32);
#pragma unroll
        for (int ii = 0; ii < 8; ++ii) { const int pp = hw + 16 * ii;
            float v[8] = {bflo(raw[ii].x), bfhi(raw[ii].x), bflo(raw[ii].y), bfhi(raw[ii].y), bflo(raw[ii].z), bfhi(raw[ii].z), bflo(raw[ii].w), bfhi(raw[ii].w)};
            float s = 0.f;
#pragma unroll
            for (int i = 0; i < 8; ++i) { v[i] = gelu_tanh(v[i]); s += v[i]; }
            s = sum32(s);
            const float mean = s * (1.f / 256.f); float q = 0.f;
#pragma unroll
            for (int i = 0; i < 8; ++i) { v[i] -= mean; q += v[i] * v[i]; }
            q = sum32(q);
            const float rstd = rsqrtf(q * (1.f / 256.f) + 1e-6f);
#pragma unroll
            for (int i = 0; i < 8; ++i) v[i] = v[i] * rstd * gg[i] + bb[i];
            *(LAS u32x4*)(lds + (r32 >> 3) * 16384 + v_st(pp, (r32 & 7) * 8)) = pk8(v);
        }
    }
    __syncthreads();
    {
        const int g = wave >> 1, ph = wave & 1;
        const bf16* Wg = (const bf16*)(a.ws + WS_SGW) + (size_t)(l * 4 + g) * 128 * 128;
        const int vb = (int)(unsigned)(uintptr_t)(lds + g * 16384) + v_rd_base(lane);
        f32x16 acc[2][2];
#pragma unroll
        for (int i = 0; i < 2; ++i)
#pragma unroll
            for (int j = 0; j < 2; ++j) acc[i][j] = f32x16{};
#define SG_STEP(KS) do { \
            const bf16x8 a0 = wa[KS][0], a1 = wa[KS][1]; \
            const s16x4 l0 = tr_read<v_rd_off(0, KS, 0)>(vb), h0 = tr_read<v_rd_off(0, KS, 1)>(vb), l1 = tr_read<v_rd_off(1, KS, 0)>(vb), h1 = tr_read<v_rd_off(1, KS, 1)>(vb); \
            asm volatile("s_waitcnt lgkmcnt(0)" ::: "memory"); SBAR(); \
            acc[0][0] = MFMA32(a0, PKV(l0, h0), acc[0][0]); acc[0][1] = MFMA32(a0, PKV(l1, h1), acc[0][1]); \
            acc[1][0] = MFMA32(a1, PKV(l0, h0), acc[1][0]); acc[1][1] = MFMA32(a1, PKV(l1, h1), acc[1][1]); } while (0)
        SG_STEP(0); SG_STEP(1); SG_STEP(2); SG_STEP(3); SG_STEP(4); SG_STEP(5); SG_STEP(6); SG_STEP(7);
#undef SG_STEP
        const bf16* zu = Z + (size_t)R0 * DIN + 1280 + g * 64 + r32; bf16* yo = Y + (size_t)R0 * DM + 512 + g * 64 + r32; const float* sgb = a.sg_b + (l * 4 + g) * 128;
#pragma unroll
        for (int pb = 0; pb < 2; ++pb) {
            unsigned short uu[16][2]; float bsv[16];
#pragma unroll
            for (int r = 0; r < 16; ++r) { const unsigned p = 64 * ph + 32 * pb + crow(r, hi); bsv[r] = sgb[p];
                uu[r][0] = zu[p * (unsigned)DIN]; uu[r][1] = zu[p * (unsigned)DIN + 32u]; }
#pragma unroll
            for (int r = 0; r < 16; ++r) { const unsigned p = 64 * ph + 32 * pb + crow(r, hi);
#pragma unroll
                for (int d0 = 0; d0 < 2; ++d0)
                    yo[p * (unsigned)DM + 32u * d0] = (bf16)(pk2(gelu_tanh(bf2f(uu[r][d0])) * (acc[pb][d0][r] + bsv[r]), 0.f) & 0xffffu); }
        }
    }
    __syncthreads();
}

constexpr int AT_K = 0, AT_KB = 128 * 144, AT_V = 2 * AT_KB, AT_VB = 16384, AT_WS = AT_V + 2 * AT_VB, AT_ST = AT_WS + 2048, AT_END = AT_ST + 4 * 8192;
static_assert(AT_END <= 131072, "attention LDS map");
constexpr float AT_THR = 8.f;
typedef float f32x2_t __attribute__((ext_vector_type(2))); typedef __bf16 bf16x2_t __attribute__((ext_vector_type(2)));
__device__ __forceinline__ unsigned cvtpk_s(float lo, float hi) { f32x2_t v = {lo, hi}; bf16x2_t b = __builtin_convertvector(v, bf16x2_t); return __builtin_bit_cast(unsigned, b); }
__device__ __forceinline__ float max3f(float a, float b, float c) { float r; asm("v_max3_f32 %0, %1, %2, %3" : "=v"(r) : "v"(a), "v"(b), "v"(c)); return r; }
__device__ __forceinline__ float max2f(float a, float b) { float r; asm("v_max_f32_e32 %0, %1, %2" : "=v"(r) : "v"(a), "v"(b)); return r; }
#define AT_SUBTILE(SUB, FIRST) do { \
    f32x16 p0 = MFMA32(k0, q0, negm); p0 = MFMA32(k1, q1, p0); \
    f32x16 p1 = MFMA32(k2, q0, negm); p1 = MFMA32(k3, q1, p1); \
    SBAR(); \
    const s16x4 va0 = tr_read<v_rd_off(0, SUB * 4 + 0, 0)>(vb), vb0_ = tr_read<v_rd_off(0, SUB * 4 + 0, 1)>(vb), va1 = tr_read<v_rd_off(0, SUB * 4 + 1, 0)>(vb), vb1_ = tr_read<v_rd_off(0, SUB * 4 + 1, 1)>(vb); \
    const s16x4 va2 = tr_read<v_rd_off(0, SUB * 4 + 2, 0)>(vb), vb2_ = tr_read<v_rd_off(0, SUB * 4 + 2, 1)>(vb), va3 = tr_read<v_rd_off(0, SUB * 4 + 3, 0)>(vb), vb3_ = tr_read<v_rd_off(0, SUB * 4 + 3, 1)>(vb); \
    const s16x4 wa0 = tr_read<v_rd_off(1, SUB * 4 + 0, 0)>(vb), wb0 = tr_read<v_rd_off(1, SUB * 4 + 0, 1)>(vb), wa1 = tr_read<v_rd_off(1, SUB * 4 + 1, 0)>(vb), wb1 = tr_read<v_rd_off(1, SUB * 4 + 1, 1)>(vb); \
    const s16x4 wa2 = tr_read<v_rd_off(1, SUB * 4 + 2, 0)>(vb), wb2 = tr_read<v_rd_off(1, SUB * 4 + 2, 1)>(vb), wa3 = tr_read<v_rd_off(1, SUB * 4 + 3, 0)>(vb), wb3 = tr_read<v_rd_off(1, SUB * 4 + 3, 1)>(vb); \
    if (SUB == 0) { k0 = *(const LAS bf16x8*)(kp + 64 * 144); k1 = *(const LAS bf16x8*)(kp + 64 * 144 + 32); k2 = *(const LAS bf16x8*)(kp + 96 * 144); k3 = *(const LAS bf16x8*)(kp + 96 * 144 + 32); } \
    SBAR(); \
    asm volatile("s_nop 15\n\ts_nop 7" : "+v"(p0), "+v"(p1)); \
    float ma = max3f(p0[0], p0[1], p1[0]), mb = max3f(p0[2], p0[3], p1[1]); ma = max3f(ma, p1[2], p1[3]); \
    _Pragma("unroll") for (int r = 4; r < 16; r += 4) { ma = max3f(ma, p0[r], p0[r + 1]); mb = max3f(mb, p0[r + 2], p0[r + 3]); ma = max3f(ma, p1[r], p1[r + 1]); mb = max3f(mb, p1[r + 2], p1[r + 3]); } \
    float rm = max2f(ma, mb); \
    { auto rr = __builtin_amdgcn_permlane32_swap(__float_as_uint(rm), __float_as_uint(rm), false, false); rm = max2f(__uint_as_float(rr[0]), __uint_as_float(rr[1])); } \
    if ((FIRST) || __any(rm > AT_THR)) { \
        const float dl = (FIRST) ? rm : max2f(rm, 0.f); \
        m += dl; \
        _Pragma("unroll") for (int r = 0; r < 16; ++r) { p0[r] -= dl; p1[r] -= dl; negm[r] = -m; } \
        if (!(FIRST)) { \
            const float f = __builtin_amdgcn_exp2f(-dl); \
            if (hi == 0) wsf[r32] = f; \
            asm volatile("s_waitcnt lgkmcnt(0)" ::: "memory"); \
            _Pragma("unroll") for (int r = 0; r < 16; ++r) { const float fr = wsf[crow(r, hi)]; o0[r] *= fr; o1[r] *= fr; lacc[r] *= fr; } \
        } \
    } \
    _Pragma("unroll") for (int r = 0; r < 16; ++r) { p0[r] = __builtin_amdgcn_exp2f(p0[r]); p1[r] = __builtin_amdgcn_exp2f(p1[r]); } \
    bf16x8 pa0, pa1, pa2, pa3; \
    PK4(p0, 0, pa0); PK4(p0, 8, pa1); PK4(p1, 0, pa2); PK4(p1, 8, pa3); \
    asm volatile("s_waitcnt lgkmcnt(0)" ::: "memory"); SBAR(); \
    o0 = MFMA32(pa0, PKV(va0, vb0_), o0); o1 = MFMA32(pa0, PKV(wa0, wb0), o1); lacc = MFMA32(pa0, ones, lacc); \
    o0 = MFMA32(pa1, PKV(va1, vb1_), o0); o1 = MFMA32(pa1, PKV(wa1, wb1), o1); lacc = MFMA32(pa1, ones, lacc); \
    o0 = MFMA32(pa2, PKV(va2, vb2_), o0); o1 = MFMA32(pa2, PKV(wa2, wb2), o1); lacc = MFMA32(pa2, ones, lacc); \
    o0 = MFMA32(pa3, PKV(va3, vb3_), o0); o1 = MFMA32(pa3, PKV(wa3, wb3), o1); lacc = MFMA32(pa3, ones, lacc); \
    SBAR(); \
} while (0)
#define PK4(P, BASE, OUT) do { u32x4 w_ = {cvtpk_s(P[BASE + 0], P[BASE + 1]), cvtpk_s(P[BASE + 2], P[BASE + 3]), cvtpk_s(P[BASE + 4], P[BASE + 5]), cvtpk_s(P[BASE + 6], P[BASE + 7])}; \
    OUT = __builtin_bit_cast(bf16x8, w_); } while (0)
__device__ __forceinline__ void attn_tile(const LAS unsigned char* Kc  , int vb, const bf16x8 q0, const bf16x8 q1, f32x16& negm, float& m,
                                          f32x16& o0, f32x16& o1, f32x16& lacc, bool first, LAS float* wsf, int r32, int hi) {
    const LAS unsigned char* kp = Kc + r32 * 144 + hi * 16;
    const bf16x8 ones = {0x3F80, 0x3F80, 0x3F80, 0x3F80, 0x3F80, 0x3F80, 0x3F80, 0x3F80};
    bf16x8 k0 = *(const LAS bf16x8*)(kp), k1 = *(const LAS bf16x8*)(kp + 32), k2 = *(const LAS bf16x8*)(kp + 32 * 144), k3 = *(const LAS bf16x8*)(kp + 32 * 144 + 32);
    AT_SUBTILE(0, first);
    AT_SUBTILE(1, false);
}
#undef PK4
#undef AT_SUBTILE

template <int VAR>
__device__ __forceinline__ void attn_unit(const Args& a, int l, int b, int h, int qrow0  , bool ctxu, const bf16* Z, bf16* Y, LAS unsigned char* lds) {
    const int tid = opaque_tid(), lane = tid & 63, wave = __builtin_amdgcn_readfirstlane(tid >> 6), r32 = lane & 31, hi = lane >> 5;
    const int comp = wave >> 2, wq = wave & 3;
    const int NT = ctxu ? 2 : 66;
    const bf16* kcp = (const bf16*)(a.ws + WS_KC) + (size_t)(b * 4 + h) * 8448 * 64; const bf16* vcp = (const bf16*)(a.ws + WS_VC) + (size_t)(b * 4 + h) * 8448 * 64;
    bf16x8 q0, q1;
    { const bf16* qp = Z + (size_t)(qrow0 + wq * 32 + r32) * DIN + 512 + h * 64 + comp * 32 + hi * 8; q0 = *(const bf16x8*)(qp); q1 = *(const bf16x8*)(qp + 16); }
    const int sr = tid >> 3, sc = (tid & 7) * 8;
    const int kst0 = sr * 144 + sc * 2, kst1 = kst0 + 64 * 144, vst0 = v_st_nat(sr, sc), vst1 = v_st_nat(sr + 64, sc);
    const int vb0 = (int)(unsigned)(uintptr_t)(lds + AT_V) + v_rd_base(lane);
    LAS float* wsf = (LAS float*)(lds + AT_WS) + wave * 64;
    f32x16 negm = f32x16{}, o0 = f32x16{}, o1 = f32x16{}, lacc = f32x16{};
    float m = 0.f;
    bf16x8 ka0, ka1, va0, va1, kb0, kb1, vb0_, vb1_;
#define AT_LOAD(K0, K1, V0, V1, T) do { const size_t e_ = (size_t)(128 * (T) + sr) * 64 + sc; \
        K0 = *(const bf16x8*)(kcp + e_); V0 = *(const bf16x8*)(vcp + e_); K1 = *(const bf16x8*)(kcp + e_ + 64 * 64); V1 = *(const bf16x8*)(vcp + e_ + 64 * 64); } while (0)
#define AT_STORE(K0, K1, V0, V1, BUF) do { *(LAS bf16x8*)(lds + AT_K + (BUF) * AT_KB + kst0) = K0; *(LAS bf16x8*)(lds + AT_K + (BUF) * AT_KB + kst1) = K1; \
        *(LAS bf16x8*)(lds + AT_V + (BUF) * AT_VB + vst0) = V0; *(LAS bf16x8*)(lds + AT_V + (BUF) * AT_VB + vst1) = V1; } while (0)
    AT_LOAD(ka0, ka1, va0, va1, 0); AT_LOAD(kb0, kb1, vb0_, vb1_, 1); AT_STORE(ka0, ka1, va0, va1, 0);
    const LAS unsigned char* Kb0 = lds + AT_K + comp * 64;
    for (int t = 0; t < NT; t += 2) {
        __syncthreads();
        if (t + 2 < NT) AT_LOAD(ka0, ka1, va0, va1, t + 2);
        attn_tile(Kb0, vb0, q0, q1, negm, m, o0, o1, lacc, t == 0, wsf, r32, hi);
        AT_STORE(kb0, kb1, vb0_, vb1_, 1);
        __syncthreads();
        if (t + 3 < NT) AT_LOAD(kb0, kb1, vb0_, vb1_, t + 3);
        attn_tile(Kb0 + AT_KB, vb0 + AT_VB, q0, q1, negm, m, o0, o1, lacc, false, wsf, r32, hi);
        if (t + 2 < NT) AT_STORE(ka0, ka1, va0, va1, 0);
    }
#undef AT_LOAD
#undef AT_STORE
    float lam, omli;
    { float s1 = 0.f, s2 = 0.f;
      for (int i = 0; i < 32; ++i) { s1 += a.lam_q1[l * 32 + i] * a.lam_k1[l * 32 + i]; s2 += a.lam_q2[l * 32 + i] * a.lam_k2[l * 32 + i]; }
      const float li = 0.8f - 0.6f * expf(-0.3f * (float)l); lam = expf(s1) - expf(s2) + li; omli = 1.f - li; }
    LAS float* stg = (LAS float*)(lds + AT_ST) + wq * 2048;
    if (comp == 1) {
#pragma unroll
        for (int r = 0; r < 16; ++r) { const int qr = crow(r, hi); const float il = lam * __builtin_amdgcn_rcpf(lacc[r]); stg[qr * 64 + r32] = o0[r] * il; stg[qr * 64 + 32 + r32] = o1[r] * il; }
    }
    __syncthreads();
    if (comp == 0) {
#pragma unroll
        for (int r = 0; r < 16; ++r) { const int qr = crow(r, hi); const float il = __builtin_amdgcn_rcpf(lacc[r]); o0[r] = o0[r] * il - stg[qr * 64 + r32]; o1[r] = o1[r] * il - stg[qr * 64 + 32 + r32]; }
        asm volatile("s_waitcnt lgkmcnt(0)" ::: "memory");
#pragma unroll
        for (int r = 0; r < 16; ++r) { const int qr = crow(r, hi); stg[qr * 64 + r32] = o0[r]; stg[qr * 64 + 32 + r32] = o1[r]; }
        asm volatile("s_waitcnt lgkmcnt(0)" ::: "memory");
        const int ch = lane & 7;
        float gsub[8];
#pragma unroll
        for (int i = 0; i < 8; ++i) gsub[i] = a.subln_g[l * 64 + ch * 8 + i] * omli;
#pragma unroll
        for (int i = 0; i < 4; ++i) { const int row = i * 8 + (lane >> 3);
            const f32x4 x0 = *(const LAS f32x4*)(stg + row * 64 + ch * 8), x1 = *(const LAS f32x4*)(stg + row * 64 + ch * 8 + 4);
            float ss = (x0.x * x0.x + x0.y * x0.y) + (x0.z * x0.z + x0.w * x0.w) + (x1.x * x1.x + x1.y * x1.y) + (x1.z * x1.z + x1.w * x1.w);
            ss = sum8(ss);
            const float rs = rsqrtf(ss * (1.f / 64.f) + 1e-6f);
            float o[8] = {x0.x * rs * gsub[0], x0.y * rs * gsub[1], x0.z * rs * gsub[2], x0.w * rs * gsub[3], x1.x * rs * gsub[4], x1.y * rs * gsub[5], x1.z * rs * gsub[6], x1.w * rs * gsub[7]};
            *(u32x4*)(Y + (size_t)(qrow0 + wq * 32 + row) * DM + 256 + h * 64 + ch * 8) = pk8(o); }
    }
    __syncthreads();
}

#define XB_TMO      128
#define XB_XCNT(j)  (256  + 64 * (j))
#define XB_XSUB(j)  (1280 + 64 * (j))
#define XB_XGEN(j)  (2304 + 64 * (j))
#define XB_TOP      3328
#define XB_TOPGEN   3392
#define XCD_BAR_WORDS 3456
#define XB_SPIN_CAP (1u << 18)

__device__ __forceinline__ unsigned xb_ld(unsigned* p)              { return __hip_atomic_load(p, __ATOMIC_RELAXED, __HIP_MEMORY_SCOPE_AGENT); }
__device__ __forceinline__ unsigned xb_add(unsigned* p, unsigned v) { return __hip_atomic_fetch_add(p, v, __ATOMIC_RELAXED, __HIP_MEMORY_SCOPE_AGENT); }
__device__ __forceinline__ unsigned xb_xcc_id() { return (unsigned)__builtin_amdgcn_s_getreg((3 << 11) | 20) & 0xFu; }
#define XB_SPIN(cond, bar) do { unsigned _sp = 0; while (cond) { __builtin_amdgcn_s_sleep(1); \
    if ((++_sp & 255u) == 0u) { if (xb_ld(&(bar)[XB_TMO])) break; if (_sp > XB_SPIN_CAP) { atomicAdd(&(bar)[XB_TMO], 1u); break; } } } } while (0)

struct XcdBarrier {
    unsigned* bar; unsigned x;
    volatile LAS unsigned* st;
};

__device__ __forceinline__ XcdBarrier xcd_barrier_post(unsigned* bar, volatile LAS unsigned* st) {
    XcdBarrier b; b.bar = bar; b.x = xb_xcc_id(); b.st = st;
    if (threadIdx.x == 0) (void)xb_add(&bar[XB_XCNT(b.x)], 1u);
    return b;
}
__device__ __forceinline__ void xcd_barrier_complete(unsigned* bar, unsigned x, unsigned& nloc, unsigned& nx) {
    const unsigned G = gridDim.x * gridDim.y * gridDim.z;
    unsigned sum, cnt, mine, sp = 0u;
    for (;;) {
        sum = 0u; cnt = 0u; mine = 0u;
#pragma unroll
        for (unsigned j = 0; j < 16; ++j) { const unsigned c = xb_ld(&bar[XB_XCNT(j)]); sum += c; cnt += (c > 0u) ? 1u : 0u; mine = (j == x) ? c : mine; }
        if (sum == G) break;
        __builtin_amdgcn_s_sleep(1);
        if ((++sp & 255u) == 0u) { if (xb_ld(&bar[XB_TMO])) break; if (sp > XB_SPIN_CAP) { atomicAdd(&bar[XB_TMO], 1u); break; } }
    }
    nloc = mine > 0u ? mine : 1u; nx = cnt > 0u ? cnt : 1u;
}

__device__ __forceinline__ void xcd_barrier(const XcdBarrier& b) {
    asm volatile("s_waitcnt vmcnt(0)" ::: "memory");
    __syncthreads();
    if (threadIdx.x == 0) {
        unsigned* bar = b.bar;
        __builtin_amdgcn_s_waitcnt(0);
        unsigned nloc = b.st[0], nx = b.st[1];
        if (nloc == 0u) { xcd_barrier_complete(bar, b.x, nloc, nx); b.st[0] = nloc; b.st[1] = nx; }
        const unsigned old = xb_add(&bar[XB_XSUB(b.x)], 1u);
        const unsigned gen = old / nloc;
        if (old + 1u == (gen + 1u) * nloc) {
            __builtin_amdgcn_fence(__ATOMIC_RELEASE, "agent");
            asm volatile("s_waitcnt vmcnt(0)" ::: "memory");
            const unsigned og = xb_add(&bar[XB_TOP], 1u);
            const unsigned tg = og / nx;
            if (og + 1u == (tg + 1u) * nx) xb_add(&bar[XB_TOPGEN], 1u);
            else XB_SPIN(xb_ld(&bar[XB_TOPGEN]) == tg, bar);
            __builtin_amdgcn_fence(__ATOMIC_ACQUIRE, "agent");
            xb_add(&bar[XB_XGEN(b.x)], 1u);
            asm volatile("s_waitcnt vmcnt(0)" ::: "memory");
        } else {
            XB_SPIN(xb_ld(&bar[XB_XGEN(b.x)]) == gen, bar);
            __builtin_amdgcn_fence(__ATOMIC_ACQUIRE, "agent");
            asm volatile("s_waitcnt vmcnt(0)" ::: "memory");
        }
    }
    __syncthreads();
}

__global__ void __launch_bounds__(512, 2) fwd_megakernel(Args a) {
    extern __shared__ __attribute__((aligned(16))) unsigned char lds_raw[];
    LAS unsigned char* lds = (LAS unsigned char*)lds_raw;
    const int G = gridDim.x, blk = blockIdx.x;
    unsigned char* ws = a.ws;
    bf16* XN = (bf16*)(ws + WS_XN); bf16* Zb = (bf16*)(ws + WS_Z); bf16* Yb = (bf16*)(ws + WS_Y); bf16* Hb = (bf16*)(ws + WS_H);
    float* XC = (float*)(ws + WS_XC); bf16* XB = (bf16*)(ws + WS_XB); const float* mod = (const float*)(ws + WS_MOD);
    const float* rc = (const float*)(ws + WS_ROPE); const float* rs = rc + 1024;
    const int lo = a.ph_lo, hi_ = a.ph_hi;
    volatile LAS unsigned* MISC = (volatile LAS unsigned*)(lds + 131072 + 64);
    if (threadIdx.x < 4) MISC[threadIdx.x] = 0u;
    __syncthreads();
    XcdBarrier bar; bar.bar = (unsigned*)ws + 1024; bar.x = 0; bar.st = nullptr;
    if (hi_ - lo > 1) bar = xcd_barrier_post((unsigned*)ws + 1024, MISC);
#define IN(k) (lo <= (k) && (k) < hi_)
#define SEAM(k) do { if (IN(k) && IN((k) + 1)) { if (lo < 0) { __threadfence(); cg::this_grid().sync(); } else xcd_barrier(bar); } } while (0)
    #ifndef SKIP_PRO
    if (IN(0)) { for (int rep_ = 0; rep_ < PROBE_LIGHT; ++rep_) phase_prologue(a, lds, G); }
#endif
    SEAM(0);
    for (int l = 0; l < 2; ++l) {
        const int P = 1 + 7 * l;
        const float* modl = mod + (size_t)l * 5 * 6144;
        const int rows_all = NROWS, rows_mix = (l == 0) ? NROWS : NLAT;
        if (IN(P)) for (int rep_ = 0; rep_ < PROBE_LIGHT; ++rep_) phase_modnorm(l == 0 ? a.x : nullptr, XB, l == 0 ? a.ctx : XC, XN, a.norm1_g + l * DM, modl, modl + 1024, rows_all, G);
        SEAM(P);
#ifndef SKIP_G1
        if (IN(P + 1)) { pg8::Gemm g{XN, (const bf16*)(ws + WS_WIN) + (size_t)l * DIN * DM, rows_all, DIN, DM, DM}; pg8::StaticOrder S; S.init(rows_all, DIN, G, blk);
            pg8::EpiZ E{Zb, rc, rs, (bf16*)(ws + WS_KC), (bf16*)(ws + WS_VC)}; pg8::gemm_phase<pg8::EpiZ, pg8::StaticOrder, true, true>(lds, g, S, E); }
#endif
        SEAM(P + 1);
        if (IN(P + 2)) {
            const int n_conv = rows_mix / 64, n_sg = rows_mix / 128, n_at = 512 + (l == 0 ? 16 : 0);
#ifndef SKIP_SG
            for (int rep_ = 0; rep_ < PROBE_LIGHT; ++rep_) for (int u = (blk + 3 * G / 4) % G; u < n_sg; u += G) sg_unit(a, l, u, Zb, Yb, lds);
#endif
#ifndef SKIP_CONV
            for (int rep_ = 0; rep_ < PROBE_LIGHT; ++rep_) for (int u = (blk + G / 2) % G; u < n_conv; u += G) conv_unit(a, l, u, Zb, Yb, lds);
#endif
#ifndef SKIP_ATTN
            for (int rep_ = 0; rep_ < PROBE_ATT; ++rep_) {
            {
                const int xcd = blk & 7, cu = blk >> 3, per = G >> 3;
                const bool xm = (G & 7) == 0;
                for (int i = 0;; ++i) { const int j = xm ? cu + i * per : blk + i * G; if (j >= (xm ? 128 : 1024)) break;
                    const int bh = xm ? xcd * 2 + (j >> 6) : (j >> 6), qb = j & 63; if (rep_ == 0) attn_unit<0>(a, l, bh >> 2, bh & 3, (bh >> 2) * SEQ + qb * 128, false, Zb, Yb, lds); else attn_unit<PROBE_VAR>(a, l, bh >> 2, bh & 3, (bh >> 2) * SEQ + qb * 128, false, Zb, (bf16*)(ws + 384 * MiB), lds); }
            }
            if (l == 0 && rep_ == 0) for (int u = (blk + G / 4) % G; u < 32; u += G) { const int bh = u >> 1; attn_unit<0>(a, l, bh >> 2, bh & 3, NLAT + (bh >> 2) * NCTX + (u & 1) * 128, true, Zb, Yb, lds); }
            }
#endif
        }
        SEAM(P + 2);
#ifndef SKIP_G2
        if (IN(P + 3)) { pg8::Gemm g{Yb, (const bf16*)(ws + WS_WOUT) + (size_t)l * DM * DM, rows_mix, DM, DM, DM}; pg8::StaticOrder S; S.init(rows_mix, DM, G, blk);
            pg8::EpiRes E{l == 0 ? a.x : nullptr, XB, l == 0 ? a.ctx : XC, XB, XC, modl + 2 * 1024}; pg8::gemm_phase<pg8::EpiRes, pg8::StaticOrder, true, true>(lds, g, S, E); }
#endif
        SEAM(P + 3);
        if (IN(P + 4)) for (int rep_ = 0; rep_ < PROBE_LIGHT; ++rep_) phase_modnorm(nullptr, XB, XC, XN, a.norm2_g + l * DM, modl + 3 * 1024, modl + 4 * 1024, rows_mix, G);
        SEAM(P + 4);
#ifndef SKIP_G3
        if (IN(P + 5)) { pg8::Gemm g{XN, (const bf16*)(ws + WS_W1) + (size_t)l * DFF * DM, rows_mix, DFF, DM, DM}; pg8::StaticOrder S; S.init(rows_mix, DFF, G, blk);
            pg8::EpiRelu2 E{Hb}; pg8::gemm_phase<pg8::EpiRelu2, pg8::StaticOrder, true, true>(lds, g, S, E); }
#endif
        SEAM(P + 5);
#ifndef SKIP_G2
        if (IN(P + 6)) { pg8::Gemm g{Hb, (const bf16*)(ws + WS_W2) + (size_t)l * DM * DFF, NLAT, DM, DFF, DFF}; pg8::StaticOrder S; S.init(NLAT, DM, G, blk);
            pg8::EpiRes E{nullptr, XB, XC, XB, XC, modl + 5 * 1024}; pg8::gemm_phase<pg8::EpiRes, pg8::StaticOrder, true, true>(lds, g, S, E);
            if (l == 0) {
                pg8::Gemm gc{Hb, (const bf16*)(ws + WS_W2), NROWS, DM, 1024, DFF}; pg8::CtxSplitOrder Sc{G, blk};
                pg8::EpiResAtomicCtx Ec{XC, modl + 5 * 1024}; pg8::gemm_phase<pg8::EpiResAtomicCtx, pg8::CtxSplitOrder, true, true>(lds, gc, Sc, Ec); } }
#endif
        SEAM(P + 6);
    }
    if (IN(15)) phase_finalnorm(XB, a.out, a.final_g, G);
#undef IN
#undef SEAM
}

#ifndef PROBE_ATT
#define PROBE_ATT 1
#endif
#ifndef MK_SINGLE
#define MK_SINGLE 1
#endif
extern "C" void kernel_launch(void* const* d_in, const int* in_sizes, int n_in, void* d_out, int out_size, void* d_ws, size_t ws_size, hipStream_t stream) {
    static int grid = 0;
    if (grid == 0) {
        if (n_in != 27 || in_sizes[0] != NLAT * DM || out_size != NLAT * DM || ws_size < WS_VC + (size_t)16 * 8448 * 64 * 2) { fprintf(stderr, "kernel_launch: unexpected shapes (n_in %d, in0 %d, out %d, ws %zu < %zu)\n", n_in, n_in > 0 ? in_sizes[0] : -1, out_size, ws_size, (size_t)WS_END); grid = -1; return; }
        if (hipFuncSetAttribute((const void*)fwd_megakernel, hipFuncAttributeMaxDynamicSharedMemorySize, LDS_BYTES) != hipSuccess) { fprintf(stderr, "kernel_launch: hipFuncSetAttribute failed\n"); grid = -1; return; }
        int dev = 0, cus = 0, per_cu = 0;
        hipGetDevice(&dev); hipDeviceGetAttribute(&cus, hipDeviceAttributeMultiprocessorCount, dev);
        hipOccupancyMaxActiveBlocksPerMultiprocessor(&per_cu, (const void*)fwd_megakernel, 512, LDS_BYTES);
        if (per_cu < 1) { fprintf(stderr, "kernel_launch: occupancy query says %d blocks per CU\n", per_cu); per_cu = 1; }
        (void)hipGetLastError();
        grid = cus;
    }
    if (grid < 0) return;
    Args a{};
    const float** f = (const float**)&a;
    for (int i = 0; i < 27; ++i) f[i] = (const float*)d_in[i];
    a.out = (float*)d_out; a.ws = (unsigned char*)d_ws;
#if MK_SINGLE
    if (hipMemsetAsync(d_ws, 0, 32768, stream) != hipSuccess) { fprintf(stderr, "kernel_launch: memset failed\n"); return; }
    a.ph_lo = 0; a.ph_hi = NPHASE;
    void* args[] = {&a};
    hipError_t e = hipLaunchCooperativeKernel((const void*)fwd_megakernel, dim3(grid), dim3(512), args, LDS_BYTES, stream);
    if (e != hipSuccess) fprintf(stderr, "kernel_launch: cooperative launch failed: %s (grid %d)\n", hipGetErrorString(e), grid);
#else
    for (int p = 0; p < NPHASE; ++p) { a.ph_lo = p; a.ph_hi = p + 1; hipLaunchKernelGGL(fwd_megakernel, dim3(grid), dim3(512), LDS_BYTES, stream, a); }
#endif
}
```
